# Optimizing an MI355X kernel written in HIP

```python
import math
import jax, jax.numpy as jnp
from jax import lax
import numpy as np

D_MODEL = 1024
BATCH = 8
SEQ = 4096
DEPTH = 2

GRID_W = 64
HEAD_DIM = 64
BLOCK = 128
A_HEADS = 8
A_KV = 2
B_HEADS = 8
B_KV = 2
WINDOW = 128
C_HEADS = 16
NA_ROWS = 8
NA_COLS = 16
MEM_LEN = 256
M_HEADS = 4
M_HEAD_DIM = 128
MEM_W = M_HEADS * M_HEAD_DIM
REL_BUCKETS = 32
REL_MAX_DIST = 128
ROPE_THETA = 10000.0
EPS = 1e-6
MIX_EVEN = A_HEADS * HEAD_DIM + B_HEADS * HEAD_DIM + MEM_W
MIX_ODD = C_HEADS * HEAD_DIM + MEM_W
SPLIT_EVEN = [A_HEADS * HEAD_DIM, A_KV * HEAD_DIM, A_KV * HEAD_DIM,
              B_HEADS * HEAD_DIM, B_KV * HEAD_DIM, B_KV * HEAD_DIM,
              MEM_W, MIX_EVEN]
SPLIT_ODD = [C_HEADS * HEAD_DIM, C_HEADS * HEAD_DIM, C_HEADS * HEAD_DIM,
             MEM_W, MIX_ODD]
IN_EVEN = sum(SPLIT_EVEN)
IN_ODD = sum(SPLIT_ODD)
N_EVEN = (DEPTH + 1) // 2
N_ODD = DEPTH // 2

kernel_name = "hybrid_grid_encoder_block"


def rmsnorm(x, g):
    xf = x.astype(jnp.float32)
    y = xf * lax.rsqrt(jnp.mean(xf * xf, axis=-1, keepdims=True) + EPS)
    return (y * g.astype(jnp.float32)).astype(x.dtype)


def split_cols(z, sizes):
    offs = [int(v) for v in np.cumsum(sizes)[:-1]]
    return jnp.split(z, offs, axis=-1)


def _rotate_axis(xa, ang):
    x1, x2 = jnp.split(xa, 2, axis=-1)
    c = jnp.cos(ang)[None, :, None, :]
    s = jnp.sin(ang)[None, :, None, :]
    return jnp.concatenate([x1 * c - x2 * s, x1 * s + x2 * c], axis=-1)


def rope_2d(x, row, col):
    half = x.shape[-1] // 2
    nf = half // 2
    freqs = jnp.power(ROPE_THETA, -jnp.arange(nf, dtype=jnp.float32) / nf)
    xf = x.astype(jnp.float32)
    ang_r = row.astype(jnp.float32)[:, None] * freqs
    ang_c = col.astype(jnp.float32)[:, None] * freqs
    out = jnp.concatenate([_rotate_axis(xf[..., :half], ang_r),
                           _rotate_axis(xf[..., half:], ang_c)], axis=-1)
    return out.astype(x.dtype)


def t5_bucket(rel):
    nb = REL_BUCKETS // 2
    max_exact = nb // 2
    ret = jnp.where(rel > 0, nb, 0)
    n = jnp.abs(rel)
    nf = jnp.maximum(n, 1).astype(jnp.float32)
    large = max_exact + (jnp.log(nf / max_exact) / math.log(REL_MAX_DIST / max_exact)
                         * (nb - max_exact)).astype(jnp.int32)
    large = jnp.minimum(large, nb - 1)
    return ret + jnp.where(n < max_exact, n, large)


def global_gqa(q, k, v):
    B, S, Hq, dh = q.shape
    Hkv = k.shape[2]
    G = Hq // Hkv
    nb = S // BLOCK
    scale = dh ** -0.5
    qb = q.reshape(B, nb, BLOCK, Hkv, G, dh).transpose(1, 0, 2, 3, 4, 5)

    def one(qblk):
        s = jnp.einsum('bqkgd,bskd->bkgqs', qblk, k).astype(jnp.float32) * scale
        p = jax.nn.softmax(s, axis=-1).astype(v.dtype)
        return jnp.einsum('bkgqs,bskd->bqkgd', p, v)

    o = lax.map(one, qb)
    return o.transpose(1, 0, 2, 3, 4, 5).reshape(B, S, Hq * dh)


def window_gqa(q, k, v, sink, rel_bias):
    B, S, Hq, dh = q.shape
    Hkv = k.shape[2]
    G = Hq // Hkv
    nb = S // BLOCK
    span = BLOCK + 2 * WINDOW
    scale = dh ** -0.5
    kp = jnp.pad(k, ((0, 0), (WINDOW, WINDOW), (0, 0), (0, 0)))
    vp = jnp.pad(v, ((0, 0), (WINDOW, WINDOW), (0, 0), (0, 0)))
    qpos = jnp.arange(BLOCK)
    kpos = jnp.arange(span) - WINDOW
    rel = kpos[None, :] - qpos[:, None]
    band = jnp.abs(rel) <= WINDOW
    bias = rel_bias.astype(jnp.float32)[t5_bucket(rel)]
    bias = bias.transpose(2, 0, 1).reshape(Hkv, G, BLOCK, span)
    sk = sink.astype(jnp.float32).reshape(Hkv, G)[None, :, :, None, None]
    qb = q.reshape(B, nb, BLOCK, Hkv, G, dh).transpose(1, 0, 2, 3, 4, 5)

    def one(args):
        i, qblk = args
        start = i * BLOCK
        kb = lax.dynamic_slice_in_dim(kp, start, span, axis=1)
        vb = lax.dynamic_slice_in_dim(vp, start, span, axis=1)
        apos = start + kpos
        valid = band & (apos >= 0)[None, :] & (apos < S)[None, :]
        s = jnp.einsum('bqkgd,bskd->bkgqs', qblk, kb).astype(jnp.float32) * scale + bias
        s = jnp.where(valid, s, -jnp.inf)
        m = jnp.maximum(jnp.max(s, axis=-1, keepdims=True), sk)
        p = jnp.exp(s - m)
        denom = jnp.sum(p, axis=-1, keepdims=True) + jnp.exp(sk - m)
        return jnp.einsum('bkgqs,bskd->bqkgd', (p / denom).astype(v.dtype), vb)

    o = lax.map(one, (jnp.arange(nb), qb))
    return o.transpose(1, 0, 2, 3, 4, 5).reshape(B, S, Hq * dh)


def neighborhood_attn(q, k, v, rpb):
    B, S, H, dh = q.shape
    rows = S // GRID_W
    kr = min(NA_ROWS, rows)
    scale = dh ** -0.5
    qg = q.reshape(B, rows, GRID_W, H, dh)
    kg = k.reshape(B, rows, GRID_W, H, dh)
    vg = v.reshape(B, rows, GRID_W, H, dh)
    col = jnp.arange(GRID_W)
    cs = jnp.clip(col - NA_COLS // 2, 0, GRID_W - NA_COLS)
    colmask = (col[None, :] >= cs[:, None]) & (col[None, :] < cs[:, None] + NA_COLS)
    dc = jnp.clip(col[None, :] - col[:, None] + NA_COLS - 1, 0, 2 * NA_COLS - 2)
    rpb_cols = rpb.astype(jnp.float32)[:, :, dc]

    def one(r):
        rs = jnp.clip(r - kr // 2, 0, rows - kr)
        kblk = lax.dynamic_slice_in_dim(kg, rs, kr, axis=1)
        vblk = lax.dynamic_slice_in_dim(vg, rs, kr, axis=1)
        qblk = lax.dynamic_index_in_dim(qg, r, axis=1, keepdims=False)
        dr = rs + jnp.arange(kr) - r + NA_ROWS - 1
        bias = jnp.take(rpb_cols, dr, axis=1).transpose(0, 2, 1, 3)
        s = jnp.einsum('bqhd,bikhd->bhqik', qblk, kblk).astype(jnp.float32) * scale + bias
        s = jnp.where(colmask[:, None, :], s, -jnp.inf)
        p = jax.nn.softmax(s.reshape(B, H, GRID_W, kr * GRID_W), axis=-1)
        p = p.reshape(B, H, GRID_W, kr, GRID_W).astype(v.dtype)
        return jnp.einsum('bhqik,bikhd->bqhd', p, vblk)

    o = lax.map(one, jnp.arange(rows))
    return o.transpose(1, 0, 2, 3, 4).reshape(B, S, H * dh)


def memory_attn(q, mk, mv):
    B, S, Hm, dm = q.shape
    s = jnp.einsum('bshd,bmhd->bhsm', q, mk).astype(jnp.float32) * (dm ** -0.5)
    p = jax.nn.softmax(s, axis=-1).astype(mv.dtype)
    return jnp.einsum('bhsm,bmhd->bshd', p, mv).reshape(B, S, Hm * dm)


def setup_inputs(seed: int = 0) -> dict:
    key = jax.random.key(seed)
    ks = jax.random.split(key, 16)
    f32 = jnp.float32
    nrm = lambda k, shp: jax.random.normal(k, shp, dtype=f32)
    return {
        "x": nrm(ks[0], (BATCH, SEQ, D_MODEL)),
        "mem": nrm(ks[1], (BATCH, MEM_LEN, D_MODEL)),
        "norm_gain": 1.0 + 0.05 * nrm(ks[2], (DEPTH, D_MODEL)),
        "mem_norm_gain": 1.0 + 0.05 * nrm(ks[3], (D_MODEL,)),
        "w_in_even": nrm(ks[4], (N_EVEN, D_MODEL, IN_EVEN)) * D_MODEL ** -0.5,
        "w_out_even": nrm(ks[5], (N_EVEN, MIX_EVEN, D_MODEL)) * MIX_EVEN ** -0.5,
        "q_norm_a": 1.0 + 0.05 * nrm(ks[6], (N_EVEN, HEAD_DIM)),
        "k_norm_a": 1.0 + 0.05 * nrm(ks[7], (N_EVEN, HEAD_DIM)),
        "sink_b": 0.5 * nrm(ks[8], (N_EVEN, B_HEADS)),
        "rel_bias": 0.5 * nrm(ks[9], (REL_BUCKETS, B_HEADS)),
        "w_in_odd": nrm(ks[10], (N_ODD, D_MODEL, IN_ODD)) * D_MODEL ** -0.5,
        "w_out_odd": nrm(ks[11], (N_ODD, MIX_ODD, D_MODEL)) * MIX_ODD ** -0.5,
        "rpb_c": 0.5 * nrm(ks[12], (N_ODD, C_HEADS, 2 * NA_ROWS - 1, 2 * NA_COLS - 1)),
        "w_mem_kv": nrm(ks[13], (DEPTH, D_MODEL, 2 * MEM_W)) * D_MODEL ** -0.5,
        "final_norm_gain": 1.0 + 0.05 * nrm(ks[14], (D_MODEL,)),
    }


def reference(x, mem, norm_gain, mem_norm_gain, w_in_even, w_out_even, q_norm_a, k_norm_a,
              sink_b, rel_bias, w_in_odd, w_out_odd, rpb_c, w_mem_kv, final_norm_gain):
    B, S, _ = x.shape
    t = jnp.arange(S)
    grid_row = t // GRID_W
    grid_col = t % GRID_W
    memn = rmsnorm(mem, mem_norm_gain)
    Mlen = mem.shape[1]
    for l in range(DEPTH):
        h = rmsnorm(x, norm_gain[l])
        mk, mv = jnp.split(memn @ w_mem_kv[l], 2, axis=-1)
        mk = mk.reshape(B, Mlen, M_HEADS, M_HEAD_DIM)
        mv = mv.reshape(B, Mlen, M_HEADS, M_HEAD_DIM)
        if l % 2 == 0:
            e = l // 2
            qa, ka, va, qb, kb, vb, qm, gate = split_cols(h @ w_in_even[e], SPLIT_EVEN)
            qa = rope_2d(rmsnorm(qa.reshape(B, S, A_HEADS, HEAD_DIM), q_norm_a[e]), grid_row, grid_col)
            ka = rope_2d(rmsnorm(ka.reshape(B, S, A_KV, HEAD_DIM), k_norm_a[e]), grid_row, grid_col)
            ya = global_gqa(qa, ka, va.reshape(B, S, A_KV, HEAD_DIM))
            yb = window_gqa(qb.reshape(B, S, B_HEADS, HEAD_DIM),
                            kb.reshape(B, S, B_KV, HEAD_DIM),
                            vb.reshape(B, S, B_KV, HEAD_DIM), sink_b[e], rel_bias)
            ym = memory_attn(qm.reshape(B, S, M_HEADS, M_HEAD_DIM), mk, mv)
            y = jnp.concatenate([ya, yb, ym], axis=-1) * jax.nn.silu(gate)
            x = x + y @ w_out_even[e]
        else:
            o = l // 2
            qc, kc, vc, qm, gate = split_cols(h @ w_in_odd[o], SPLIT_ODD)
            yc = neighborhood_attn(qc.reshape(B, S, C_HEADS, HEAD_DIM),
                                   kc.reshape(B, S, C_HEADS, HEAD_DIM),
                                   vc.reshape(B, S, C_HEADS, HEAD_DIM), rpb_c[o])
            ym = memory_attn(qm.reshape(B, S, M_HEADS, M_HEAD_DIM), mk, mv)
            y = jnp.concatenate([yc, ym], axis=-1) * jax.nn.silu(gate)
            x = x + y @ w_out_odd[o]
    return rmsnorm(x, final_norm_gain)
```

```cpp
#include <hip/hip_runtime.h>
#include <hip/hip_cooperative_groups.h>
#include <hip/hip_bf16.h>
#include <cstdio>
#include <cstdint>
#include <cmath>
namespace cg = cooperative_groups;

#define LAS __attribute__((address_space(3)))
#define DEV __device__ __forceinline__
typedef unsigned short bf16_t;
typedef short bf16x8 __attribute__((ext_vector_type(8)));
typedef short s16x4 __attribute__((ext_vector_type(4)));
typedef float f32x4 __attribute__((ext_vector_type(4)));
typedef float f32x16 __attribute__((ext_vector_type(16)));
typedef unsigned u32x4 __attribute__((ext_vector_type(4)));
typedef unsigned u32x2 __attribute__((ext_vector_type(2)));

constexpr int NB = 8, SEQ = 4096, DM = 1024, MTOK = NB * SEQ, MEML = 256;
constexpr int IN0 = 3584, IN1 = 5120, MIX = 1536;
constexpr float EPSN = 1e-6f;
constexpr float LOG2E = 1.4426950408889634f;
constexpr float C2_64 = 0.125f * LOG2E;
constexpr float C2_128 = 0.08838834764831845f * LOG2E;
constexpr int Z0_QA = 0, Z0_KA = 512, Z0_VA = 640, Z0_QB = 768, Z0_KB = 1280, Z0_VB = 1408, Z0_QM = 1536, Z0_G = 2048;
constexpr int Z1_QC = 0, Z1_KC = 1024, Z1_VC = 2048, Z1_QM = 3072, Z1_G = 3584;

constexpr size_t MiB = 1u << 20;
constexpr size_t WS_CTL = 0;
constexpr size_t WS_TAB = 1 * MiB;
constexpr int TAB_COS = 0, TAB_SIN = 1024, TAB_BIASB = 2048, TAB_RPB = 2048 + 8 * 384, TAB_END = TAB_RPB + 16 * 15 * 32;
constexpr size_t WS_WIN0 = 2 * MiB, WS_WIN1 = 9 * MiB, WS_WOUT0 = 19 * MiB, WS_WOUT1 = 22 * MiB, WS_WMKV = 25 * MiB, WS_MEMN = 29 * MiB, WS_MKV = 33 * MiB;
constexpr size_t WS_SSQ0 = 41 * MiB, WS_SSQ1 = 43 * MiB, WS_SSQ2 = 45 * MiB;
constexpr size_t WS_XB = 48 * MiB, WS_Z = 112 * MiB, WS_END = 432 * MiB;

constexpr int RING_BYTES = 131072;
constexpr int LDS_TAB_OFF = 98304;
constexpr int LDS_BYTES = 147456;

DEV unsigned f2bf(float f) { unsigned u = __builtin_bit_cast(unsigned, f); return (u + 0x7fffu + ((u >> 16) & 1u)) >> 16; }
DEV unsigned pk2(float lo, float hi) { return f2bf(lo) | (f2bf(hi) << 16); }
DEV float bflo(unsigned u) { return __builtin_bit_cast(float, u << 16); }
DEV float bfhi(unsigned u) { return __builtin_bit_cast(float, u & 0xffff0000u); }
DEV float wave_sum(float v) {
#pragma unroll
    for (int o = 1; o < 64; o <<= 1) v += __shfl_xor(v, o);
    return v;
}

namespace pg8 {
constexpr int BM = 256, BK = 64, HALF = 128, HTB = HALF * BK * 2, STAGE_BYTES = 8 * HTB, NXCD = 8, WGM = 8;
__host__ __device__ __forceinline__ int lds_byte(int r, int c) { const int st = (r >> 4) * 2 + (c >> 5), rr = r & 15, cc = c & 31, ob = rr * 64 + cc * 2; return st * 1024 + (ob ^ (((ob >> 9) & 1) << 5)); }
__host__ __device__ __forceinline__ void stage_rc(int b, int& R, int& C) { const int st = b / 1024, sb = b % 1024, swz = sb ^ (((sb >> 9) & 1) << 5); R = (st >> 1) * 16 + swz / 64; C = (st & 1) * 32 + (swz % 64) / 2; }

struct Unit { int pm, pn; };
struct Gemm { const bf16_t* A; const bf16_t* Bt; int M, N, K, lda; };

struct StaticOrder {
    int nM, nN, nwg, G, c;
    __host__ __device__ void init(int M, int N, int G_, int c_) { nM = M / BM; nN = N / BM; nwg = nM * nN; G = G_; c = c_; }
    __host__ __device__ bool next(int i, Unit& u) const {
        const long L = (long)i * G + c; if (L >= nwg) return false;
        int wgid = (int)L; { const int q = nwg / NXCD, r = nwg % NXCD, xcd = wgid % NXCD, off = wgid / NXCD; wgid = (xcd < r ? xcd * (q + 1) : r * (q + 1) + (xcd - r) * q) + off; }
        const int nig = WGM * nN, gid = wgid / nig, fm = gid * WGM, gsz = (nM - fm) < WGM ? (nM - fm) : WGM;
        u.pm = fm + ((wgid % nig) % gsz); u.pn = (wgid % nig) / gsz; return true;
    }
};

template <class Epi, class Sched, bool ALIGN_EPI = false>
__device__ __forceinline__ void gemm_phase(LAS unsigned char* lds, const Gemm g, const Sched& S, const Epi& E) {
    const int tid = threadIdx.x, wid = __builtin_amdgcn_readfirstlane(tid >> 6), lane = tid & 63, wr = wid >> 2, wc = wid & 3, fr = lane & 15, fq = lane >> 4;
    const int K = g.K, nt = K / BK, lda = g.lda;
    unsigned voffA[2], voffB[2];
#pragma unroll
    for (int i = 0; i < 2; ++i) { int R, C; stage_rc(tid * 16 + i * 8192, R, C);
        voffA[i] = (unsigned)(R * lda + C) * 2u; voffB[i] = (unsigned)(R * K + C) * 2u; }
    const size_t kstep = (size_t)(BK * 2);
    const size_t hstepA = (size_t)HALF * lda * 2, hstepB = (size_t)HALF * K * 2;
    const size_t tstepA = 2 * hstepA, tstepB = 2 * hstepB;
    const unsigned ldsw = (unsigned)wid * 1024u;
    const int aoff = lds_byte(wr * 64 + fr, fq * 8), boff = lds_byte(wc * 32 + fr, fq * 8);
#define PG8_SA(b, h) (((b) * 2 + (h)) * HTB)
#define PG8_SB(b, h) ((4 + (b) * 2 + (h)) * HTB)
#define PG8_STAGE(bufoff, gbase, voff) do { _Pragma("unroll") for (int _i = 0; _i < 2; ++_i) \
        __builtin_amdgcn_global_load_lds((const unsigned*)((const char*)(gbase) + (voff)[_i]), (LAS unsigned*)(lds + (bufoff) + ldsw + _i * 8192), 16, 0, 0); } while (0)
#define PG8_LDA(dst, b, h) do { _Pragma("unroll") for (int m = 0; m < 4; ++m) _Pragma("unroll") for (int k = 0; k < 2; ++k) dst[m][k] = *(const LAS bf16x8*)(lds + PG8_SA(b, h) + aoff + m * 2048 + k * 1024); } while (0)
#define PG8_LDB(dst, b, h) do { _Pragma("unroll") for (int n = 0; n < 2; ++n) _Pragma("unroll") for (int k = 0; k < 2; ++k) dst[n][k] = *(const LAS bf16x8*)(lds + PG8_SB(b, h) + boff + n * 2048 + k * 1024); } while (0)
#define PG8_MMA(ai, bj, At, Bt) do { __builtin_amdgcn_s_setprio(1); _Pragma("unroll") for (int m = 0; m < 4; ++m) _Pragma("unroll") for (int n = 0; n < 2; ++n) _Pragma("unroll") for (int k = 0; k < 2; ++k) \
        acc[ai][bj][m][n] = __builtin_amdgcn_mfma_f32_16x16x32_bf16(Bt[n][k], At[m][k], acc[ai][bj][m][n], 0, 0, 0); __builtin_amdgcn_s_setprio(0); } while (0)
#define PG8_WAIT_V(n) asm volatile("s_waitcnt vmcnt(" #n ")" ::: "memory")
#define PG8_WAIT_L(n) asm volatile("s_waitcnt lgkmcnt(" #n ")" ::: "memory")
#define PG8_BAR __builtin_amdgcn_s_barrier()
#define PG8_SCHED __builtin_amdgcn_sched_barrier(0)
    Unit cur, nxt; int ui = 0;
    if (!S.next(0, cur)) return;
    f32x4 acc[2][2][4][2];
#pragma unroll
    for (int a = 0; a < 2; ++a)
#pragma unroll
        for (int b = 0; b < 2; ++b)
#pragma unroll
            for (int m = 0; m < 4; ++m)
#pragma unroll
                for (int n = 0; n < 2; ++n) acc[a][b][m][n] = (f32x4){0.f, 0.f, 0.f, 0.f};
    bf16x8 At[4][2], B0[2][2], B1[2][2];
    const char* cA = (const char*)g.A + (size_t)cur.pm * tstepA; const char* cB = (const char*)g.Bt + (size_t)cur.pn * tstepB;
    PG8_STAGE(PG8_SB(0, 0), cB, voffB); PG8_STAGE(PG8_SB(0, 1), cB + hstepB, voffB); PG8_STAGE(PG8_SA(0, 0), cA, voffA); PG8_STAGE(PG8_SA(0, 1), cA + hstepA, voffA);
    if (wr == 1) PG8_BAR;
    PG8_WAIT_V(2); PG8_BAR;
    PG8_STAGE(PG8_SB(1, 0), cB + kstep, voffB); PG8_STAGE(PG8_SA(1, 0), cA + kstep, voffA); PG8_STAGE(PG8_SB(1, 1), cB + hstepB + kstep, voffB);
    PG8_WAIT_V(6); PG8_BAR;
    for (;;) {
        const bool has_next = S.next(ui + 1, nxt);
        const char* nA = has_next ? (const char*)g.A + (size_t)nxt.pm * tstepA : cA; const char* nB = has_next ? (const char*)g.Bt + (size_t)nxt.pn * tstepB : cB;
        for (int t = 0; t < nt; t += 2) {
            const bool last = (t == nt - 2);
            const char* a1 = cA + (size_t)(t + 1) * kstep;
            const char* a2 = last ? nA : cA + (size_t)(t + 2) * kstep; const char* b2 = last ? nB : cB + (size_t)(t + 2) * kstep;
            const char* a3 = a2 + kstep; const char* b3 = b2 + kstep;
            PG8_LDB(B0, 0, 0); PG8_LDB(B1, 0, 1); PG8_SCHED; PG8_LDA(At, 0, 0); PG8_STAGE(PG8_SA(1, 1), a1 + hstepA, voffA);
            PG8_WAIT_V(8); PG8_WAIT_L(0); PG8_BAR; PG8_MMA(0, 0, At, B0); PG8_MMA(0, 1, At, B1); PG8_BAR; PG8_SCHED;
            PG8_LDA(At, 0, 1); PG8_STAGE(PG8_SB(0, 0), b2, voffB); PG8_STAGE(PG8_SB(0, 1), b2 + hstepB, voffB); PG8_STAGE(PG8_SA(0, 0), a2, voffA);
            PG8_WAIT_V(8); PG8_WAIT_L(0); PG8_BAR; PG8_MMA(1, 0, At, B0); PG8_MMA(1, 1, At, B1); PG8_BAR; PG8_SCHED;
            PG8_LDB(B0, 1, 0); PG8_LDB(B1, 1, 1); PG8_SCHED; PG8_LDA(At, 1, 0); PG8_STAGE(PG8_SA(0, 1), a2 + hstepA, voffA);
            PG8_WAIT_V(8); PG8_WAIT_L(0); PG8_BAR; PG8_MMA(0, 0, At, B0); PG8_MMA(0, 1, At, B1); PG8_BAR; PG8_SCHED;
            PG8_LDA(At, 1, 1); PG8_STAGE(PG8_SB(1, 0), b3, voffB); PG8_STAGE(PG8_SB(1, 1), b3 + hstepB, voffB); PG8_STAGE(PG8_SA(1, 0), a3, voffA);
            PG8_WAIT_V(8); PG8_WAIT_L(0); PG8_BAR; PG8_MMA(1, 0, At, B0); PG8_MMA(1, 1, At, B1); PG8_BAR; PG8_SCHED;
        }
        if constexpr (ALIGN_EPI) { if (wr == 0) PG8_BAR; }
        E(acc, cur, wr, wc, fr, fq);
        if (!has_next) break;
#pragma unroll
        for (int a = 0; a < 2; ++a)
#pragma unroll
            for (int b = 0; b < 2; ++b)
#pragma unroll
                for (int m = 0; m < 4; ++m)
#pragma unroll
                    for (int n = 0; n < 2; ++n) acc[a][b][m][n] = (f32x4){0.f, 0.f, 0.f, 0.f};
        cur = nxt; cA = nA; cB = nB; ++ui;
        if constexpr (ALIGN_EPI) { if (wr == 1) PG8_BAR; }
    }
    PG8_WAIT_V(0);
    if constexpr (!ALIGN_EPI) { if (wr == 0) PG8_BAR; }
    PG8_BAR;
#undef PG8_SA
#undef PG8_SB
#undef PG8_STAGE
#undef PG8_LDA
#undef PG8_LDB
#undef PG8_MMA
#undef PG8_WAIT_V
#undef PG8_WAIT_L
#undef PG8_BAR
#undef PG8_SCHED
}

struct EpiIn {
    bf16_t* Z; int ldz; const float* ssq; int layer; const float* qg; const float* kg; const float* tab;
    __device__ __forceinline__ void operator()(const f32x4 (&acc)[2][2][4][2], const Unit& u, int wr, int wc, int fr, int fq) const {
        const int cb = u.pn * BM + wc * 64;
        int kind = 0; float sc = 1.f; const float* g = qg;
        if (layer == 0) {
            if (cb < Z0_KA) { kind = 1; g = qg; sc = C2_64; }
            else if (cb < Z0_VA) { kind = 1; g = kg; sc = 1.f; }
            else if (cb < Z0_QB) kind = 0;
            else if (cb < Z0_KB) { kind = 2; sc = C2_64; }
            else if (cb < Z0_QM) kind = 0;
            else if (cb < Z0_G) { kind = 2; sc = C2_128; }
            else kind = 3;
        } else {
            if (cb < Z1_KC) { kind = 2; sc = C2_64; }
            else if (cb < Z1_QM) kind = 0;
            else if (cb < Z1_G) { kind = 2; sc = C2_128; }
            else kind = 3;
        }
#pragma unroll
        for (int ai = 0; ai < 2; ++ai)
#pragma unroll
            for (int m = 0; m < 4; ++m) {
                const int row = u.pm * BM + ai * HALF + wr * 64 + m * 16 + fr;
                const f32x4* sp = (const f32x4*)(ssq + (size_t)row * 16);
                const f32x4 s0 = sp[0], s1 = sp[1], s2 = sp[2], s3 = sp[3];
                const float tot = (((s0[0] + s0[1]) + (s0[2] + s0[3])) + ((s1[0] + s1[1]) + (s1[2] + s1[3]))) + (((s2[0] + s2[1]) + (s2[2] + s2[3])) + ((s3[0] + s3[1]) + (s3[2] + s3[3])));
                const float rstd = 1.0f / sqrtf(tot * (1.0f / DM) + EPSN);
                f32x4 v[2][2];
#pragma unroll
                for (int bj = 0; bj < 2; ++bj)
#pragma unroll
                    for (int n = 0; n < 2; ++n) v[bj][n] = acc[ai][bj][m][n] * rstd;
                if (kind == 1) {
                    float ss = 0.f;
#pragma unroll
                    for (int bj = 0; bj < 2; ++bj)
#pragma unroll
                        for (int n = 0; n < 2; ++n) ss += (v[bj][n][0] * v[bj][n][0] + v[bj][n][1] * v[bj][n][1]) + (v[bj][n][2] * v[bj][n][2] + v[bj][n][3] * v[bj][n][3]);
                    ss += __shfl_xor(ss, 16); ss += __shfl_xor(ss, 32);
                    const float hr = 1.0f / sqrtf(ss * (1.0f / 64.0f) + EPSN);
#pragma unroll
                    for (int bj = 0; bj < 2; ++bj)
#pragma unroll
                        for (int n = 0; n < 2; ++n) { const f32x4 gv = *(const f32x4*)(g + 32 * bj + 16 * n + 4 * fq); v[bj][n] = v[bj][n] * hr * gv; }
                    const int pos = row & (SEQ - 1);
#pragma unroll
                    for (int bj = 0; bj < 2; ++bj) {
                        const int p = bj == 0 ? (pos >> 6) : (pos & 63);
                        const f32x4 cs = *(const f32x4*)(tab + TAB_COS + p * 16 + 4 * fq), sn = *(const f32x4*)(tab + TAB_SIN + p * 16 + 4 * fq);
                        const f32x4 x1 = v[bj][0], x2 = v[bj][1];
                        v[bj][0] = (x1 * cs - x2 * sn) * sc; v[bj][1] = (x1 * sn + x2 * cs) * sc;
                    }
                } else if (kind == 2) {
#pragma unroll
                    for (int bj = 0; bj < 2; ++bj)
#pragma unroll
                        for (int n = 0; n < 2; ++n) v[bj][n] = v[bj][n] * sc;
                } else if (kind == 3) {
#pragma unroll
                    for (int bj = 0; bj < 2; ++bj)
#pragma unroll
                        for (int n = 0; n < 2; ++n)
#pragma unroll
                            for (int j = 0; j < 4; ++j) { const float x = v[bj][n][j]; v[bj][n][j] = x / (1.0f + __expf(-x)); }
                }
                bf16_t* zp = Z + (size_t)row * ldz + cb + 4 * fq;
#pragma unroll
                for (int bj = 0; bj < 2; ++bj)
#pragma unroll
                    for (int n = 0; n < 2; ++n) { u32x2 w; w.x = pk2(v[bj][n][0], v[bj][n][1]); w.y = pk2(v[bj][n][2], v[bj][n][3]); *(u32x2*)(zp + 32 * bj + 16 * n) = w; }
            }
    }
};
struct EpiPlain {
    bf16_t* O; int ldc;
    __device__ __forceinline__ void operator()(const f32x4 (&acc)[2][2][4][2], const Unit& u, int wr, int wc, int fr, int fq) const {
#pragma unroll
        for (int ai = 0; ai < 2; ++ai)
#pragma unroll
            for (int m = 0; m < 4; ++m) {
                const int row = u.pm * BM + ai * HALF + wr * 64 + m * 16 + fr;
                bf16_t* op = O + (size_t)row * ldc + u.pn * BM + wc * 32 + 4 * fq;
#pragma unroll
                for (int bj = 0; bj < 2; ++bj)
#pragma unroll
                    for (int n = 0; n < 2; ++n) { const f32x4 x = acc[ai][bj][m][n]; u32x2 w; w.x = pk2(x[0], x[1]); w.y = pk2(x[2], x[3]); *(u32x2*)(op + bj * HALF + 16 * n) = w; }
            }
    }
};
struct EpiOut {
    const float* resid; float* xo; bf16_t* xb; float* ssq;
    __device__ __forceinline__ void operator()(const f32x4 (&acc)[2][2][4][2], const Unit& u, int wr, int wc, int fr, int fq) const {
#pragma unroll
        for (int ai = 0; ai < 2; ++ai)
#pragma unroll
            for (int m = 0; m < 4; ++m) {
                const int row = u.pm * BM + ai * HALF + wr * 64 + m * 16 + fr;
                const size_t off = (size_t)row * DM + u.pn * BM + wc * 32 + 4 * fq;
                float ss = 0.f;
#pragma unroll
                for (int bj = 0; bj < 2; ++bj)
#pragma unroll
                    for (int n = 0; n < 2; ++n) {
                        const f32x4 r = *(const f32x4*)(resid + off + bj * HALF + 16 * n);
                        const f32x4 x = acc[ai][bj][m][n] + r;
                        *(f32x4*)(xo + off + bj * HALF + 16 * n) = x;
                        u32x2 w; w.x = pk2(x[0], x[1]); w.y = pk2(x[2], x[3]); *(u32x2*)(xb + off + bj * HALF + 16 * n) = w;
                        ss += (x[0] * x[0] + x[1] * x[1]) + (x[2] * x[2] + x[3] * x[3]);
                    }
                ss += __shfl_xor(ss, 16); ss += __shfl_xor(ss, 32);
                if (fq == 0) ssq[(size_t)row * 16 + u.pn * 4 + wc] = ss;
            }
    }
};
}

namespace sa {
typedef LAS const char* lds_cptr;
#define SBAR() __builtin_amdgcn_sched_barrier(0)
DEV int crow(int r, int hi) { return (r & 3) + 8 * (r >> 2) + 4 * hi; }
DEV void glds16(const void* gsrc, unsigned lds_dst) { unsigned keep;
    asm volatile("s_mov_b32 %0, m0\n\ts_mov_b32 m0, %2\n\ts_nop 0\n\tglobal_load_lds_dwordx4 %1, off\n\ts_mov_b32 m0, %0" : "=&s"(keep) : "v"(gsrc), "s"(lds_dst) : "memory"); }
typedef float f32x2_t __attribute__((ext_vector_type(2))); typedef __bf16 bf16x2_t __attribute__((ext_vector_type(2)));
DEV unsigned cvtpk_s(float lo, float hi) { f32x2_t v = {lo, hi}; bf16x2_t b = __builtin_convertvector(v, bf16x2_t); return __builtin_bit_cast(unsigned, b); }
DEV float rowmax(const f32x16& p0, const f32x16& p1) {
    float a = fmaxf(p0[0], p1[0]);
#pragma unroll
    for (int r = 1; r < 16; ++r) a = fmaxf(a, fmaxf(p0[r], p1[r]));
    auto rr = __builtin_amdgcn_permlane32_swap(__float_as_uint(a), __float_as_uint(a), false, false);
    return fmaxf(__uint_as_float(rr[0]), __uint_as_float(rr[1]));
}
constexpr int OFF_K = 0, OFF_WS = 65536, OFF_OST = 0;
constexpr float NEG_INF = -__builtin_huge_valf();

template <int D, class F>
__device__ __forceinline__ void unit(char* shm, const bf16_t* Qw, int qpitch, const bf16_t* Kt, const bf16_t* Vt, int kvpitch, int nt, const F& f, bf16_t* Ow, int opitch) {
    constexpr int SLOT = 64 * D * 2, ND0 = D / 16, NDB = D / 32, NP = D / 64, OFF_V = 2 * SLOT;
    constexpr float THR = 8.0f;
    const int tid = threadIdx.x, lane = tid & 63, r32 = lane & 31, hi = lane >> 5; const int wid = __builtin_amdgcn_readfirstlane(tid >> 6);
    const unsigned lds0 = (unsigned)(uintptr_t)shm;
    const lds_cptr shm3 = (lds_cptr)shm;
    LAS float* wsf = (LAS float*)(shm3 + OFF_WS) + wid * 64;
#define SA_DMA_TILE(j, slotoff) do { const long trow_ = f.tile_row(j); \
    _Pragma("unroll") for (int p_ = 0; p_ < NP; ++p_) { const int c_ = wid + 8 * p_; glds16(Kt + (trow_ + lane) * (long)kvpitch + c_ * 8, (unsigned)__builtin_amdgcn_readfirstlane(lds0 + OFF_K + (slotoff) + c_ * 1024)); } \
    _Pragma("unroll") for (int p_ = 0; p_ < NP; ++p_) { const int bi_ = wid + 8 * p_; glds16(Vt + (trow_ + 16 * (bi_ & 3) + (lane >> 2)) * (long)kvpitch + (bi_ >> 2) * 32 + (lane & 3) * 8, (unsigned)__builtin_amdgcn_readfirstlane(lds0 + OFF_V + (slotoff) + bi_ * 1024)); } } while (0)
    SA_DMA_TILE(0, 0);
    bf16x8 qr[ND0];
#pragma unroll
    for (int d0 = 0; d0 < ND0; ++d0) qr[d0] = *reinterpret_cast<const bf16x8*>(&Qw[(long)r32 * qpitch + d0 * 16 + hi * 8]);
    float mhat = F::has_init ? f.init_m() : 0.f, l_reg = (F::has_init && hi == 0) ? 1.f : 0.f;
    bool started = F::has_init;
    f32x16 o[NDB];
#pragma unroll
    for (int d = 0; d < NDB; ++d) o[d] = f32x16{};
    f32x16 negm;
#pragma unroll
    for (int r = 0; r < 16; ++r) negm[r] = -mhat;
    const int vb0 = (int)(lds0 + OFF_V) + ((lane >> 4) & 1) * 32 + (lane & 3) * 8 + (4 * hi + ((lane & 15) >> 2)) * 64;
    for (int j = 0; j < nt; ++j) {
        const int so = (j & 1) * SLOT;
        if (j + 1 < nt) {
            SA_DMA_TILE(j + 1, ((j + 1) & 1) * SLOT);
            if constexpr (NP == 1) asm volatile("s_waitcnt vmcnt(2) lgkmcnt(0)\n\ts_barrier" ::: "memory");
            else asm volatile("s_waitcnt vmcnt(4) lgkmcnt(0)\n\ts_barrier" ::: "memory");
        } else asm volatile("s_waitcnt vmcnt(0) lgkmcnt(0)\n\ts_barrier" ::: "memory");
        if (f.active(j)) {
            const lds_cptr kp = shm3 + OFF_K + so + hi * 1024 + r32 * 16;
            f32x16 p0, p1;
#pragma unroll
            for (int d0 = 0; d0 < ND0; ++d0) {
                const bf16x8 b0 = *(const LAS bf16x8*)(kp + d0 * 2048), b1 = *(const LAS bf16x8*)(kp + d0 * 2048 + 512);
                if (d0 == 0) { p0 = __builtin_amdgcn_mfma_f32_32x32x16_bf16(b0, qr[0], negm, 0, 0, 0); p1 = __builtin_amdgcn_mfma_f32_32x32x16_bf16(b1, qr[0], negm, 0, 0, 0); }
                else { p0 = __builtin_amdgcn_mfma_f32_32x32x16_bf16(b0, qr[d0], p0, 0, 0, 0); p1 = __builtin_amdgcn_mfma_f32_32x32x16_bf16(b1, qr[d0], p1, 0, 0, 0); }
            }
            f.apply(p0, p1, j);
            const float rm = rowmax(p0, p1);
            if (!started) {
                const float dl = (rm == NEG_INF) ? 0.f : rm;
                mhat = dl;
#pragma unroll
                for (int r = 0; r < 16; ++r) { p0[r] -= dl; p1[r] -= dl; negm[r] = -mhat; }
                started = true;
            } else if (__any(rm > THR)) {
                const float dl = fmaxf(rm, 0.f); mhat += dl;
#pragma unroll
                for (int r = 0; r < 16; ++r) { p0[r] -= dl; p1[r] -= dl; negm[r] = -mhat; }
                const float fs = __builtin_amdgcn_exp2f(-dl); l_reg *= fs;
                if (hi == 0) wsf[r32] = fs;
                asm volatile("s_waitcnt lgkmcnt(0)" ::: "memory");
#pragma unroll
                for (int r = 0; r < 16; ++r) { const float fr_ = wsf[crow(r, hi)];
#pragma unroll
                    for (int d = 0; d < NDB; ++d) o[d][r] *= fr_; }
            }
            float sacc = 0.f;
#pragma unroll
            for (int r = 0; r < 16; ++r) { p0[r] = __builtin_amdgcn_exp2f(p0[r]); p1[r] = __builtin_amdgcn_exp2f(p1[r]); sacc += p0[r] + p1[r]; }
            l_reg += sacc;
            u32x4 pw[4];
#pragma unroll
            for (int q = 0; q < 4; ++q) { pw[0][q] = cvtpk_s(p0[2 * q], p0[2 * q + 1]); pw[1][q] = cvtpk_s(p0[8 + 2 * q], p0[8 + 2 * q + 1]); pw[2][q] = cvtpk_s(p1[2 * q], p1[2 * q + 1]); pw[3][q] = cvtpk_s(p1[8 + 2 * q], p1[8 + 2 * q + 1]); }
            const int vb = vb0 + so;
#pragma unroll
            for (int d0 = 0; d0 < NDB; ++d0) { s16x4 lo[4], hv[4];
#pragma unroll
                for (int ks = 0; ks < 4; ++ks) {
                    asm volatile("ds_read_b64_tr_b16 %0,%1 offset:%c2" : "=&v"(lo[ks]) : "v"(vb), "i"(d0 * 4096 + ks * 1024) : "memory");
                    asm volatile("ds_read_b64_tr_b16 %0,%1 offset:%c2" : "=&v"(hv[ks]) : "v"(vb), "i"(d0 * 4096 + ks * 1024 + 512) : "memory"); }
                asm volatile("s_waitcnt lgkmcnt(0)" ::: "memory"); SBAR();
#pragma unroll
                for (int ks = 0; ks < 4; ++ks) { const bf16x8 vf = (bf16x8){lo[ks][0], lo[ks][1], lo[ks][2], lo[ks][3], hv[ks][0], hv[ks][1], hv[ks][2], hv[ks][3]};
                    o[d0] = __builtin_amdgcn_mfma_f32_32x32x16_bf16(__builtin_bit_cast(bf16x8, pw[ks]), vf, o[d0], 0, 0, 0); }
            }
        }
        asm volatile("s_waitcnt lgkmcnt(0)\n\ts_barrier" ::: "memory");
    }
#undef SA_DMA_TILE
    { auto rr = __builtin_amdgcn_permlane32_swap(__float_as_uint(l_reg), __float_as_uint(l_reg), false, false); l_reg = __uint_as_float(rr[0]) + __uint_as_float(rr[1]); }
    if (hi == 0) wsf[32 + r32] = l_reg;
    asm volatile("s_waitcnt lgkmcnt(0)" ::: "memory");
    LAS bf16_t* stg = (LAS bf16_t*)(shm3 + OFF_OST) + wid * (32 * D);
#pragma unroll
    for (int r = 0; r < 16; ++r) { const int orow = crow(r, hi); const float rli = 1.0f / wsf[32 + orow];
#pragma unroll
        for (int d0 = 0; d0 < NDB; ++d0) stg[orow * D + d0 * 32 + r32] = (bf16_t)f2bf(o[d0][r] * rli); }
    asm volatile("s_waitcnt lgkmcnt(0)" ::: "memory");
    constexpr int CPR = D / 8, NIT = (32 * CPR) / 64;
#pragma unroll
    for (int i = 0; i < NIT; ++i) { const int idx = i * 64 + lane, row = idx / CPR, ch = idx % CPR;
        const u32x4 ov = *(const LAS u32x4*)(stg + row * D + ch * 8);
        bf16_t* gp = Ow + (long)row * opitch + ch * 8;
        const u32x4 gv = *(const u32x4*)gp; u32x4 w;
#pragma unroll
        for (int q = 0; q < 4; ++q) w[q] = pk2(bflo(ov[q]) * bflo(gv[q]), bfhi(ov[q]) * bfhi(gv[q]));
        *(u32x4*)gp = w; }
    asm volatile("s_waitcnt lgkmcnt(0)\n\ts_barrier" ::: "memory");
}
#undef SBAR

struct FDense {
    static constexpr bool has_init = false;
    DEV long tile_row(int j) const { return 64L * j; }
    DEV bool active(int) const { return true; }
    DEV float init_m() const { return 0.f; }
    DEV void apply(f32x16&, f32x16&, int) const {}
};
struct FWindow {
    static constexpr bool has_init = true;
    int t_lo; int qpos0; float sink_l2; LAS const float* tab; int r32, hi;
    DEV long tile_row(int j) const { return t_lo + 64L * j; }
    DEV bool active(int) const { return true; }
    DEV float init_m() const { return sink_l2; }
    DEV void apply(f32x16& p0, f32x16& p1, int j) const {
        LAS const float* tp = tab + (t_lo + 64 * j - qpos0 - r32 + 191 + 4 * hi);
#pragma unroll
        for (int r = 0; r < 16; ++r) { const int o = (r & 3) + 8 * (r >> 2); p0[r] += tp[o]; p1[r] += tp[32 + o]; }
    }
};
struct FNeigh {
    static constexpr bool has_init = false;
    int kr_lo, rq, rs, cq, cs; LAS const float* rpbh; int hi;
    DEV long tile_row(int j) const { return 64L * (kr_lo + j); }
    DEV bool active(int j) const { const int kr = kr_lo + j; return kr >= rs && kr <= rs + 7; }
    DEV float init_m() const { return 0.f; }
    DEV void apply(f32x16& p0, f32x16& p1, int j) const {
        const int dr = kr_lo + j - rq + 7; LAS const float* tp = rpbh + dr * 32;
#pragma unroll
        for (int r = 0; r < 16; ++r) { const int kc = (r & 3) + 8 * (r >> 2) + 4 * hi;
            { const int dc = kc - cq + 15; const bool ok = (unsigned)(kc - cs) < 16u; const float b = tp[dc & 31]; p0[r] = ok ? p0[r] + b : NEG_INF; }
            { const int k2 = kc + 32; const int dc = k2 - cq + 15; const bool ok = (unsigned)(k2 - cs) < 16u; const float b = tp[dc & 31]; p1[r] = ok ? p1[r] + b : NEG_INF; } }
    }
};
}

constexpr int NWAVES = 8;
struct Args { const float* in[15]; float* out; unsigned char* ws; int ph_lo, ph_hi; };

DEV void transpose_item(const float* W, int N, int K, bf16_t* WT, int k0, int n0, int dst_row0, const float* gain, LAS float* scr, int lane) {
#pragma unroll 8
    for (int i = 0; i < 32; ++i) { const int kk = 2 * i + (lane >> 5); scr[kk * 33 + (lane & 31)] = W[(size_t)(k0 + kk) * N + n0 + (lane & 31)]; }
    asm volatile("s_waitcnt lgkmcnt(0)" ::: "memory");
    const int c = lane & 7;
    float gk[8];
#pragma unroll
    for (int i = 0; i < 8; ++i) gk[i] = gain ? gain[k0 + 8 * c + i] : 1.0f;
#pragma unroll
    for (int j = 0; j < 4; ++j) { const int n = (lane >> 3) + 8 * j; const LAS float* s = scr + (8 * c) * 33 + n;
        u32x4 o; o.x = pk2(s[0 * 33] * gk[0], s[1 * 33] * gk[1]); o.y = pk2(s[2 * 33] * gk[2], s[3 * 33] * gk[3]); o.z = pk2(s[4 * 33] * gk[4], s[5 * 33] * gk[5]); o.w = pk2(s[6 * 33] * gk[6], s[7 * 33] * gk[7]);
        *(u32x4*)(WT + (size_t)(dst_row0 + n) * K + k0 + 8 * c) = o; }
    asm volatile("s_waitcnt lgkmcnt(0)" ::: "memory");
}
DEV int perm_row0(int n0) { const int t = n0 >> 8, gl = (n0 & 255) >> 5, wc = gl >> 1, bj = gl & 1; return (t << 8) + 32 * (4 * bj + wc); }

DEV int t5_bucket(int rel) {
    const int n = rel < 0 ? -rel : rel; int b = rel > 0 ? 16 : 0;
    if (n < 8) return b + n;
    int large = 2 + (31 - __clz(n * n)); if (large > 15) large = 15;
    return b + large;
}

__global__ void __launch_bounds__(NWAVES * 64, 2) fwd_kernel(Args args) {
    extern __shared__ __attribute__((aligned(16))) unsigned char lds[];
    cg::grid_group grid = cg::this_grid();
    const int tid = threadIdx.x, lane = tid & 63, wave = __builtin_amdgcn_readfirstlane(tid >> 6);
    const int G = gridDim.x; const int bx = blockIdx.x; const int vcu = (G % 8 == 0) ? (bx % 8) * (G / 8) + bx / 8 : bx;
    unsigned char* ws = args.ws;
    const float* x = args.in[0]; const float* mem = args.in[1]; const float* norm_gain = args.in[2]; const float* mem_gain = args.in[3];
    const float* w_in0 = args.in[4]; const float* w_out0 = args.in[5]; const float* q_norm = args.in[6]; const float* k_norm = args.in[7];
    const float* sink_b = args.in[8]; const float* rel_bias = args.in[9]; const float* w_in1 = args.in[10]; const float* w_out1 = args.in[11];
    const float* rpb_c = args.in[12]; const float* w_mkv = args.in[13]; const float* fin_gain = args.in[14];
    float* out = args.out;
    float* tab = (float*)(ws + WS_TAB);
    bf16_t* WIN0 = (bf16_t*)(ws + WS_WIN0); bf16_t* WIN1 = (bf16_t*)(ws + WS_WIN1); bf16_t* WOUT0 = (bf16_t*)(ws + WS_WOUT0); bf16_t* WOUT1 = (bf16_t*)(ws + WS_WOUT1);
    bf16_t* WMKV = (bf16_t*)(ws + WS_WMKV); bf16_t* MEMN = (bf16_t*)(ws + WS_MEMN); bf16_t* MKV = (bf16_t*)(ws + WS_MKV);
    float* SSQ0 = (float*)(ws + WS_SSQ0); float* SSQ1 = (float*)(ws + WS_SSQ1); float* SSQ2 = (float*)(ws + WS_SSQ2);
    bf16_t* XB = (bf16_t*)(ws + WS_XB); bf16_t* Z = (bf16_t*)(ws + WS_Z);
    LAS unsigned char* ldsl = (LAS unsigned char*)lds;
    const int lo = args.ph_lo, hi_ph = args.ph_hi;
#define IN(k) (lo <= (k) && (k) < hi_ph)
#define SEAM(k) do { if (IN(k) && IN((k) + 1)) grid.sync(); } while (0)
    const int gw = vcu * NWAVES + wave, NGW = G * NWAVES;

    if (IN(0)) {
        LAS float* scr = (LAS float*)(ldsl + wave * 16384);
        constexpr int I_IN0 = (DM / 64) * (IN0 / 32), I_IN1 = (DM / 64) * (IN1 / 32), I_OUT = (MIX / 64) * (DM / 32), I_MKV = (DM / 64) * (DM / 32);
        constexpr int NITEMS = I_IN0 + I_IN1 + 2 * I_OUT + 2 * I_MKV;
        for (int it = gw; it < NITEMS; it += NGW) {
            int r = it;
            if (r < I_IN0) { const int nblk = IN0 / 32, kb = r / nblk, nb = r % nblk; transpose_item(w_in0, IN0, DM, WIN0, 64 * kb, 32 * nb, perm_row0(32 * nb), norm_gain, scr, lane); continue; } r -= I_IN0;
            if (r < I_IN1) { const int nblk = IN1 / 32, kb = r / nblk, nb = r % nblk; transpose_item(w_in1, IN1, DM, WIN1, 64 * kb, 32 * nb, perm_row0(32 * nb), norm_gain + DM, scr, lane); continue; } r -= I_IN1;
            if (r < I_OUT) { const int nblk = DM / 32, kb = r / nblk, nb = r % nblk; transpose_item(w_out0, DM, MIX, WOUT0, 64 * kb, 32 * nb, 32 * nb, nullptr, scr, lane); continue; } r -= I_OUT;
            if (r < I_OUT) { const int nblk = DM / 32, kb = r / nblk, nb = r % nblk; transpose_item(w_out1, DM, MIX, WOUT1, 64 * kb, 32 * nb, 32 * nb, nullptr, scr, lane); continue; } r -= I_OUT;
            { const int l = r / I_MKV; r -= l * I_MKV; const int nblk = DM / 32, kb = r / nblk, nb = r % nblk;
              transpose_item(w_mkv + (size_t)l * DM * DM, DM, DM, WMKV, 64 * kb, 32 * nb, l * DM + 32 * nb, nullptr, scr, lane); }
        }
        for (int m = gw; m < MTOK; m += NGW) {
            const f32x4* xr = (const f32x4*)(x + (size_t)m * DM) + lane; f32x4 v[4]; float s = 0.f;
#pragma unroll
            for (int j = 0; j < 4; ++j) { v[j] = xr[64 * j]; s += (v[j][0] * v[j][0] + v[j][1] * v[j][1]) + (v[j][2] * v[j][2] + v[j][3] * v[j][3]); }
            s = wave_sum(s);
            u32x2* o8 = (u32x2*)(XB + (size_t)m * DM) + lane;
#pragma unroll
            for (int j = 0; j < 4; ++j) { u32x2 w; w.x = pk2(v[j][0], v[j][1]); w.y = pk2(v[j][2], v[j][3]); o8[64 * j] = w; }
            if (lane < 16) SSQ0[(size_t)m * 16 + lane] = lane == 0 ? s : 0.f;
        }
        for (int m = gw; m < NB * MEML; m += NGW) {
            const f32x4* xr = (const f32x4*)(mem + (size_t)m * DM) + lane; const f32x4* gr = (const f32x4*)mem_gain + lane; f32x4 v[4]; float s = 0.f;
#pragma unroll
            for (int j = 0; j < 4; ++j) { v[j] = xr[64 * j]; s += (v[j][0] * v[j][0] + v[j][1] * v[j][1]) + (v[j][2] * v[j][2] + v[j][3] * v[j][3]); }
            s = wave_sum(s); const float rstd = 1.0f / sqrtf(s * (1.0f / DM) + EPSN);
            u32x2* o8 = (u32x2*)(MEMN + (size_t)m * DM) + lane;
#pragma unroll
            for (int j = 0; j < 4; ++j) { const f32x4 g4 = gr[64 * j]; const f32x4 y = v[j] * rstd * g4; u32x2 w; w.x = pk2(y[0], y[1]); w.y = pk2(y[2], y[3]); o8[64 * j] = w; }
        }
        if (bx == 0) {
            for (int i = tid; i < 1024; i += NWAVES * 64) { const int p = i >> 4, k = i & 15;
                const float fr = (float)pow(10000.0, -(double)k / 16.0); const float ang = (float)p * fr;
                tab[TAB_COS + i] = (float)cos((double)ang); tab[TAB_SIN + i] = (float)sin((double)ang); }
            for (int i = tid; i < 8 * 384; i += NWAVES * 64) { const int h = i / 384, e = i % 384; const int rel = e - 191;
                float v = -__builtin_huge_valf();
                if (rel >= -128 && rel <= 128) v = rel_bias[t5_bucket(rel) * 8 + h] * LOG2E;
                tab[TAB_BIASB + i] = v; }
            for (int i = tid; i < 16 * 15 * 32; i += NWAVES * 64) { const int dc = i & 31, hd = i >> 5;
                tab[TAB_RPB + i] = dc < 31 ? rpb_c[hd * 31 + dc] * LOG2E : 0.f; }
        }
    }
    SEAM(0);

    if (IN(1)) {
        { pg8::Gemm g{XB, WIN0, MTOK, IN0, DM, DM}; pg8::StaticOrder S; S.init(MTOK, IN0, G, bx);
          pg8::EpiIn E{Z, IN0, SSQ0, 0, q_norm, k_norm, tab};
          pg8::gemm_phase<pg8::EpiIn, pg8::StaticOrder, true>(ldsl, g, S, E); }
        { pg8::Gemm g{MEMN, WMKV, NB * MEML, 2 * DM, DM, DM}; pg8::StaticOrder S; S.init(NB * MEML, 2 * DM, G, bx);
          pg8::EpiPlain E{MKV, 2 * DM};
          pg8::gemm_phase<pg8::EpiPlain, pg8::StaticOrder, true>(ldsl, g, S, E); }
    }
    SEAM(1);

    if (IN(2)) {
        LAS float* ltab = (LAS float*)(ldsl + LDS_TAB_OFF);
        for (int i = tid; i < 8 * 384; i += NWAVES * 64) ltab[i] = tab[TAB_BIASB + i];
        __syncthreads();
        const int r32 = lane & 31, hi = lane >> 5;
        { constexpr int NU = NB * 8 * 16; const int per = (NU + G - 1) / G;
          for (int uid = vcu * per; uid < NU && uid < (vcu + 1) * per; ++uid) {
              const int qb = uid & 15, h = (uid >> 4) & 7, b = uid >> 7, kvh = h >> 2;
              const size_t rowb = (size_t)b * SEQ;
              const bf16_t* Qw = Z + (rowb + qb * 256 + wave * 32) * IN0 + Z0_QA + h * 64;
              sa::FDense f;
              sa::unit<64, sa::FDense>((char*)lds, Qw, IN0, Z + rowb * IN0 + Z0_KA + kvh * 64, Z + rowb * IN0 + Z0_VA + kvh * 64, IN0, SEQ / 64, f,
                                       Z + (rowb + qb * 256 + wave * 32) * IN0 + Z0_G + h * 64, IN0);
          } }
        { constexpr int NU = NB * 2 * 64; const int per = (NU + G - 1) / G;
          for (int uid = vcu * per; uid < NU && uid < (vcu + 1) * per; ++uid) {
              const int qc = uid & 63, kvh = (uid >> 6) & 1, b = uid >> 7; const int q0 = qc * 64, h = kvh * 4 + (wave >> 1);
              const size_t rowb = (size_t)b * SEQ; const int qpos0 = q0 + 32 * (wave & 1);
              const int t_lo = q0 - 128 < 0 ? 0 : q0 - 128, t_hi = q0 + 192 > SEQ ? SEQ : q0 + 192;
              sa::FWindow f{t_lo, qpos0, sink_b[h] * LOG2E, ltab + h * 384, r32, hi};
              sa::unit<64, sa::FWindow>((char*)lds, Z + (rowb + qpos0) * IN0 + Z0_QB + h * 64, IN0, Z + rowb * IN0 + Z0_KB + kvh * 64, Z + rowb * IN0 + Z0_VB + kvh * 64, IN0, (t_hi - t_lo) / 64, f,
                                        Z + (rowb + qpos0) * IN0 + Z0_G + 512 + h * 64, IN0);
          } }
        { constexpr int NU = NB * 4 * 16; const int per = (NU + G - 1) / G;
          for (int uid = vcu * per; uid < NU && uid < (vcu + 1) * per; ++uid) {
              const int qb = uid & 15, hm = (uid >> 4) & 3, b = uid >> 6; const size_t rowb = (size_t)b * SEQ;
              sa::FDense f;
              sa::unit<128, sa::FDense>((char*)lds, Z + (rowb + qb * 256 + wave * 32) * IN0 + Z0_QM + hm * 128, IN0, MKV + (size_t)b * MEML * 2048 + hm * 128, MKV + (size_t)b * MEML * 2048 + 512 + hm * 128, 2048, MEML / 64, f,
                                        Z + (rowb + qb * 256 + wave * 32) * IN0 + Z0_G + 1024 + hm * 128, IN0);
          } }
    }
    SEAM(2);

    if (IN(3)) {
        pg8::Gemm g{Z + Z0_G, WOUT0, MTOK, DM, MIX, IN0}; pg8::StaticOrder S; S.init(MTOK, DM, G, bx);
        pg8::EpiOut E{x, out, XB, SSQ1};
        pg8::gemm_phase<pg8::EpiOut, pg8::StaticOrder, true>(ldsl, g, S, E);
    }
    SEAM(3);

    if (IN(4)) {
        pg8::Gemm g{XB, WIN1, MTOK, IN1, DM, DM}; pg8::StaticOrder S; S.init(MTOK, IN1, G, bx);
        pg8::EpiIn E{Z, IN1, SSQ1, 1, q_norm, k_norm, tab};
        pg8::gemm_phase<pg8::EpiIn, pg8::StaticOrder, true>(ldsl, g, S, E);
    }
    SEAM(4);

    if (IN(5)) {
        LAS float* ltab = (LAS float*)(ldsl + LDS_TAB_OFF);
        for (int i = tid; i < 16 * 15 * 32; i += NWAVES * 64) ltab[i] = tab[TAB_RPB + i];
        __syncthreads();
        const int r32 = lane & 31, hi = lane >> 5;
        { constexpr int NU = NB * 16 * 16; const int per = (NU + G - 1) / G;
          for (int uid = vcu * per; uid < NU && uid < (vcu + 1) * per; ++uid) {
              const int rg = uid & 15, h = (uid >> 4) & 15, b = uid >> 8; const size_t rowb = (size_t)b * SEQ;
              const int r0 = 4 * rg, rq = r0 + (wave >> 1), cq = 32 * (wave & 1) + r32;
              auto clip = [](int v, int a, int c) { return v < a ? a : (v > c ? c : v); };
              const int kr_lo = clip(r0 - 4, 0, 56), kr_hi = clip(r0 + 3 - 4, 0, 56) + 7;
              sa::FNeigh f{kr_lo, rq, clip(rq - 4, 0, 56), cq, clip(cq - 8, 0, 48), ltab + h * 15 * 32, hi};
              const size_t qrow = rowb + rq * 64 + 32 * (wave & 1);
              sa::unit<64, sa::FNeigh>((char*)lds, Z + qrow * IN1 + Z1_QC + h * 64, IN1, Z + rowb * IN1 + Z1_KC + h * 64, Z + rowb * IN1 + Z1_VC + h * 64, IN1, kr_hi - kr_lo + 1, f,
                                       Z + qrow * IN1 + Z1_G + h * 64, IN1);
          } }
        { constexpr int NU = NB * 4 * 16; const int per = (NU + G - 1) / G;
          for (int uid = vcu * per; uid < NU && uid < (vcu + 1) * per; ++uid) {
              const int qb = uid & 15, hm = (uid >> 4) & 3, b = uid >> 6; const size_t rowb = (size_t)b * SEQ;
              sa::FDense f;
              sa::unit<128, sa::FDense>((char*)lds, Z + (rowb + qb * 256 + wave * 32) * IN1 + Z1_QM + hm * 128, IN1, MKV + (size_t)b * MEML * 2048 + 1024 + hm * 128, MKV + (size_t)b * MEML * 2048 + 1024 + 512 + hm * 128, 2048, MEML / 64, f,
                                        Z + (rowb + qb * 256 + wave * 32) * IN1 + Z1_G + 1024 + hm * 128, IN1);
          } }
    }
    SEAM(5);

    if (IN(6)) {
        pg8::Gemm g{Z + Z1_G, WOUT1, MTOK, DM, MIX, IN1}; pg8::StaticOrder S; S.init(MTOK, DM, G, bx);
        pg8::EpiOut E{out, out, XB, SSQ2};
        pg8::gemm_phase<pg8::EpiOut, pg8::StaticOrder, true>(ldsl, g, S, E);
    }
    SEAM(6);

    if (IN(7)) {
        for (int m = gw; m < MTOK; m += NGW) {
            f32x4* xr = (f32x4*)(out + (size_t)m * DM) + lane; const f32x4* gr = (const f32x4*)fin_gain + lane;
            float s = lane < 16 ? SSQ2[(size_t)m * 16 + lane] : 0.f; s = wave_sum(s);
            const float rstd = 1.0f / sqrtf(s * (1.0f / DM) + EPSN);
#pragma unroll
            for (int j = 0; j < 4; ++j) { const f32x4 v = xr[64 * j]; xr[64 * j] = v * rstd * gr[64 * j]; }
        }
    }
#undef IN
#undef SEAM
}

#ifndef MK_N_LAUNCHES
#define MK_N_LAUNCHES 1
#endif
extern "C" void kernel_launch(void* const* d_in, const int* in_sizes, int n_in, void* d_out, int out_size, void* d_ws, size_t ws_size, hipStream_t stream) {
    static int grid = 0;
    if (grid == 0) {
        if (n_in != 15 || out_size != MTOK * DM || ws_size < WS_END) { fprintf(stderr, "kernel_launch: unexpected shapes (n_in %d out %d ws %zu)\n", n_in, out_size, ws_size); grid = -1; return; }
        int dev = 0, cus = 0, per_cu = 0;
        hipGetDevice(&dev); hipDeviceGetAttribute(&cus, hipDeviceAttributeMultiprocessorCount, dev);
        hipFuncSetAttribute((const void*)fwd_kernel, hipFuncAttributeMaxDynamicSharedMemorySize, LDS_BYTES);
        hipOccupancyMaxActiveBlocksPerMultiprocessor(&per_cu, (const void*)fwd_kernel, NWAVES * 64, LDS_BYTES);
        (void)hipGetLastError();
        if (per_cu < 1) { fprintf(stderr, "kernel_launch: occupancy query says %d blocks per CU\n", per_cu); per_cu = 1; }
        grid = cus;
    }
    if (grid < 0) return;
    Args a{};
    for (int i = 0; i < 15; ++i) a.in[i] = (const float*)d_in[i];
    a.out = (float*)d_out; a.ws = (unsigned char*)d_ws;
    if (MK_N_LAUNCHES == 1) {
        a.ph_lo = 0; a.ph_hi = 8;
        void* kargs[] = {&a};
        hipError_t e = hipLaunchCooperativeKernel((const void*)fwd_kernel, dim3(grid), dim3(NWAVES * 64), kargs, LDS_BYTES, stream);
        if (e != hipSuccess) fprintf(stderr, "cooperative launch failed: %s (grid %d)\n", hipGetErrorString(e), grid);
    } else {
        for (int p = 0; p < 8; ++p) { a.ph_lo = p; a.ph_hi = p + 1; hipLaunchKernelGGL(fwd_kernel, dim3(grid), dim3(NWAVES * 64), LDS_BYTES, stream, a); }
    }
}
```

```cpp
#include <hip/hip_runtime.h>
#include <hip/hip_bf16.h>
#include <cstdio>
#include <cstdint>
#include <cmath>

#define LAS __attribute__((address_space(3)))
#define DEV __device__ __forceinline__
typedef unsigned short bf16_t;
typedef short bf16x8 __attribute__((ext_vector_type(8)));
typedef short s16x4 __attribute__((ext_vector_type(4)));
typedef float f32x4 __attribute__((ext_vector_type(4)));
typedef float f32x16 __attribute__((ext_vector_type(16)));
typedef unsigned u32x4 __attribute__((ext_vector_type(4)));
typedef unsigned u32x2 __attribute__((ext_vector_type(2)));

constexpr int NB = 8, SEQ = 4096, DM = 1024, MTOK = NB * SEQ, MEML = 256;
constexpr int IN0 = 3584, IN1 = 5120, MIX = 1536;
constexpr float EPSN = 1e-6f;
constexpr float LOG2E = 1.4426950408889634f;
constexpr float C2_64 = 0.125f * LOG2E;
constexpr float C2_128 = 0.08838834764831845f * LOG2E;
constexpr int Z0_QA = 0, Z0_KA = 512, Z0_VA = 640, Z0_QB = 768, Z0_KB = 1280, Z0_VB = 1408, Z0_QM = 1536, Z0_G = 2048;
constexpr int Z1_QC = 0, Z1_KC = 1024, Z1_VC = 2048, Z1_QM = 3072, Z1_G = 3584;

constexpr size_t MiB = 1u << 20;
constexpr size_t WS_CTL = 0;
constexpr size_t WS_TAB = 1 * MiB;
constexpr int TAB_COS = 0, TAB_SIN = 1024, TAB_BIASB = 2048, TAB_RPB = 2048 + 8 * 384, TAB_END = TAB_RPB + 16 * 15 * 32;
constexpr size_t WS_WIN0 = 2 * MiB, WS_WIN1 = 9 * MiB, WS_WOUT0 = 19 * MiB, WS_WOUT1 = 22 * MiB, WS_WMKV = 25 * MiB, WS_MEMN = 29 * MiB, WS_MKV = 33 * MiB;
constexpr size_t WS_SSQ0 = 41 * MiB, WS_SSQ1 = 43 * MiB, WS_SSQ2 = 45 * MiB;
constexpr size_t WS_XB = 48 * MiB, WS_Z = 112 * MiB, WS_END = 432 * MiB;

constexpr int RING_BYTES = 131072;
constexpr int LDS_TAB_OFF = 98304;
constexpr int LDS_MISC_OFF = 131072 + 320;
constexpr int LDS_BYTES = 147456;
constexpr int CW_BAR = 4096;
constexpr size_t CTL_ZERO_BYTES = 65536;

DEV unsigned f2bf(float f) { unsigned u = __builtin_bit_cast(unsigned, f); return (u + 0x7fffu + ((u >> 16) & 1u)) >> 16; }
typedef float f32x2_t __attribute__((ext_vector_type(2))); typedef __bf16 bf16x2_t __attribute__((ext_vector_type(2)));
DEV unsigned pk2(float lo, float hi) { f32x2_t v = {lo, hi}; bf16x2_t b = __builtin_convertvector(v, bf16x2_t); return __builtin_bit_cast(unsigned, b); }
DEV float bflo(unsigned u) { return __builtin_bit_cast(float, u << 16); }
DEV float bfhi(unsigned u) { return __builtin_bit_cast(float, u & 0xffff0000u); }
DEV float wave_sum(float v) {
#pragma unroll
    for (int o = 1; o < 64; o <<= 1) v += __shfl_xor(v, o);
    return v;
}

namespace pg8 {
constexpr int BM = 256, BK = 64, HALF = 128, HTB = HALF * BK * 2, STAGE_BYTES = 8 * HTB, NXCD = 8, WGM = 8;
__host__ __device__ __forceinline__ int lds_byte(int r, int c) { const int st = (r >> 4) * 2 + (c >> 5), rr = r & 15, cc = c & 31, ob = rr * 64 + cc * 2; return st * 1024 + (ob ^ (((ob >> 9) & 1) << 5)); }
__host__ __device__ __forceinline__ void stage_rc(int b, int& R, int& C) { const int st = b / 1024, sb = b % 1024, swz = sb ^ (((sb >> 9) & 1) << 5); R = (st >> 1) * 16 + swz / 64; C = (st & 1) * 32 + (swz % 64) / 2; }

struct Unit { int pm, pn; };
struct Gemm { const bf16_t* A; const bf16_t* Bt; int M, N, K, lda; };

struct StaticOrder {
    int nM, nN, nwg, G, c;
    __host__ __device__ void init(int M, int N, int G_, int c_) { nM = M / BM; nN = N / BM; nwg = nM * nN; G = G_; c = c_; }
    __host__ __device__ bool next(int i, Unit& u) const {
        const long L = (long)i * G + c; if (L >= nwg) return false;
        int wgid = (int)L; { const int q = nwg / NXCD, r = nwg % NXCD, xcd = wgid % NXCD, off = wgid / NXCD; wgid = (xcd < r ? xcd * (q + 1) : r * (q + 1) + (xcd - r) * q) + off; }
        const int nig = WGM * nN, gid = wgid / nig, fm = gid * WGM, gsz = (nM - fm) < WGM ? (nM - fm) : WGM;
        u.pm = fm + ((wgid % nig) % gsz); u.pn = (wgid % nig) / gsz; return true;
    }
};

template <class Epi, class Sched, bool ALIGN_EPI = false>
__device__ __forceinline__ void gemm_phase(LAS unsigned char* lds, const Gemm g, const Sched& S, const Epi& E) {
    const int tid = threadIdx.x, wid = __builtin_amdgcn_readfirstlane(tid >> 6), lane = tid & 63, wr = wid >> 2, wc = wid & 3, fr = lane & 15, fq = lane >> 4;
    const int K = g.K, nt = K / BK, lda = g.lda;
    unsigned voffA[2], voffB[2];
#pragma unroll
    for (int i = 0; i < 2; ++i) { int R, C; stage_rc(tid * 16 + i * 8192, R, C);
        voffA[i] = (unsigned)(R * lda + C) * 2u; voffB[i] = (unsigned)(R * K + C) * 2u; }
    const size_t kstep = (size_t)(BK * 2);
    const size_t hstepA = (size_t)HALF * lda * 2, hstepB = (size_t)HALF * K * 2;
    const size_t tstepA = 2 * hstepA, tstepB = 2 * hstepB;
    const unsigned ldsw = (unsigned)wid * 1024u;
    const int aoff = lds_byte(wr * 64 + fr, fq * 8), boff = lds_byte(wc * 32 + fr, fq * 8);
#define PG8_SA(b, h) (((b) * 2 + (h)) * HTB)
#define PG8_SB(b, h) ((4 + (b) * 2 + (h)) * HTB)
#define PG8_STAGE(bufoff, gbase, voff) do { _Pragma("unroll") for (int _i = 0; _i < 2; ++_i) \
        __builtin_amdgcn_global_load_lds((const unsigned*)((const char*)(gbase) + (voff)[_i]), (LAS unsigned*)(lds + (bufoff) + ldsw + _i * 8192), 16, 0, 0); } while (0)
#define PG8_LDA(dst, b, h) do { _Pragma("unroll") for (int m = 0; m < 4; ++m) _Pragma("unroll") for (int k = 0; k < 2; ++k) dst[m][k] = *(const LAS bf16x8*)(lds + PG8_SA(b, h) + aoff + m * 2048 + k * 1024); } while (0)
#define PG8_LDB(dst, b, h) do { _Pragma("unroll") for (int n = 0; n < 2; ++n) _Pragma("unroll") for (int k = 0; k < 2; ++k) dst[n][k] = *(const LAS bf16x8*)(lds + PG8_SB(b, h) + boff + n * 2048 + k * 1024); } while (0)
#define PG8_MMA(ai, bj, At, Bt) do { __builtin_amdgcn_s_setprio(1); _Pragma("unroll") for (int m = 0; m < 4; ++m) _Pragma("unroll") for (int n = 0; n < 2; ++n) _Pragma("unroll") for (int k = 0; k < 2; ++k) \
        acc[ai][bj][m][n] = __builtin_amdgcn_mfma_f32_16x16x32_bf16(Bt[n][k], At[m][k], acc[ai][bj][m][n], 0, 0, 0); __builtin_amdgcn_s_setprio(0); } while (0)
#define PG8_WAIT_V(n) asm volatile("s_waitcnt vmcnt(" #n ")" ::: "memory")
#define PG8_WAIT_L(n) asm volatile("s_waitcnt lgkmcnt(" #n ")" ::: "memory")
#define PG8_BAR __builtin_amdgcn_s_barrier()
#define PG8_SCHED __builtin_amdgcn_sched_barrier(0)
    Unit cur, nxt; int ui = 0;
    if (!S.next(0, cur)) return;
    f32x4 acc[2][2][4][2];
#pragma unroll
    for (int a = 0; a < 2; ++a)
#pragma unroll
        for (int b = 0; b < 2; ++b)
#pragma unroll
            for (int m = 0; m < 4; ++m)
#pragma unroll
                for (int n = 0; n < 2; ++n) acc[a][b][m][n] = (f32x4){0.f, 0.f, 0.f, 0.f};
    bf16x8 At[4][2], B0[2][2], B1[2][2];
    const char* cA = (const char*)g.A + (size_t)cur.pm * tstepA; const char* cB = (const char*)g.Bt + (size_t)cur.pn * tstepB;
    PG8_STAGE(PG8_SB(0, 0), cB, voffB); PG8_STAGE(PG8_SB(0, 1), cB + hstepB, voffB); PG8_STAGE(PG8_SA(0, 0), cA, voffA); PG8_STAGE(PG8_SA(0, 1), cA + hstepA, voffA);
    if (wr == 1) PG8_BAR;
    PG8_WAIT_V(2); PG8_BAR;
    PG8_STAGE(PG8_SB(1, 0), cB + kstep, voffB); PG8_STAGE(PG8_SA(1, 0), cA + kstep, voffA); PG8_STAGE(PG8_SB(1, 1), cB + hstepB + kstep, voffB);
    PG8_WAIT_V(6); PG8_BAR;
    for (;;) {
        const bool has_next = S.next(ui + 1, nxt);
        const char* nA = has_next ? (const char*)g.A + (size_t)nxt.pm * tstepA : cA; const char* nB = has_next ? (const char*)g.Bt + (size_t)nxt.pn * tstepB : cB;
        for (int t = 0; t < nt; t += 2) {
            const bool last = (t == nt - 2);
            const char* a1 = cA + (size_t)(t + 1) * kstep;
            const char* a2 = last ? nA : cA + (size_t)(t + 2) * kstep; const char* b2 = last ? nB : cB + (size_t)(t + 2) * kstep;
            const char* a3 = a2 + kstep; const char* b3 = b2 + kstep;
            PG8_LDB(B0, 0, 0); PG8_LDB(B1, 0, 1); PG8_SCHED; PG8_LDA(At, 0, 0); PG8_STAGE(PG8_SA(1, 1), a1 + hstepA, voffA);
            PG8_WAIT_V(8); PG8_WAIT_L(0); PG8_BAR; PG8_MMA(0, 0, At, B0); PG8_MMA(0, 1, At, B1); PG8_BAR; PG8_SCHED;
            PG8_LDA(At, 0, 1); PG8_STAGE(PG8_SB(0, 0), b2, voffB); PG8_STAGE(PG8_SB(0, 1), b2 + hstepB, voffB); PG8_STAGE(PG8_SA(0, 0), a2, voffA);
            PG8_WAIT_V(8); PG8_WAIT_L(0); PG8_BAR; PG8_MMA(1, 0, At, B0); PG8_MMA(1, 1, At, B1); PG8_BAR; PG8_SCHED;
            PG8_LDB(B0, 1, 0); PG8_LDB(B1, 1, 1); PG8_SCHED; PG8_LDA(At, 1, 0); PG8_STAGE(PG8_SA(0, 1), a2 + hstepA, voffA);
            PG8_WAIT_V(8); PG8_WAIT_L(0); PG8_BAR; PG8_MMA(0, 0, At, B0); PG8_MMA(0, 1, At, B1); PG8_BAR; PG8_SCHED;
            PG8_LDA(At, 1, 1); PG8_STAGE(PG8_SB(1, 0), b3, voffB); PG8_STAGE(PG8_SB(1, 1), b3 + hstepB, voffB); PG8_STAGE(PG8_SA(1, 0), a3, voffA);
            PG8_WAIT_V(8); PG8_WAIT_L(0); PG8_BAR; PG8_MMA(1, 0, At, B0); PG8_MMA(1, 1, At, B1); PG8_BAR; PG8_SCHED;
        }
        if constexpr (ALIGN_EPI) { if (wr == 0) PG8_BAR; }
        E(acc, cur, wr, wc, fr, fq);
        if (!has_next) break;
#pragma unroll
        for (int a = 0; a < 2; ++a)
#pragma unroll
            for (int b = 0; b < 2; ++b)
#pragma unroll
                for (int m = 0; m < 4; ++m)
#pragma unroll
                    for (int n = 0; n < 2; ++n) acc[a][b][m][n] = (f32x4){0.f, 0.f, 0.f, 0.f};
        cur = nxt; cA = nA; cB = nB; ++ui;
        if constexpr (ALIGN_EPI) { if (wr == 1) PG8_BAR; }
    }
    PG8_WAIT_V(0);
    if constexpr (!ALIGN_EPI) { if (wr == 0) PG8_BAR; }
    PG8_BAR;
#undef PG8_SA
#undef PG8_SB
#undef PG8_STAGE
#undef PG8_LDA
#undef PG8_LDB
#undef PG8_MMA
#undef PG8_WAIT_V
#undef PG8_WAIT_L
#undef PG8_BAR
#undef PG8_SCHED
}

struct EpiIn {
    bf16_t* Z; int ldz; const float* ssq; int layer; const float* qg; const float* kg; const float* tab;
    __device__ __forceinline__ void operator()(const f32x4 (&acc)[2][2][4][2], const Unit& u, int wr, int wc, int fr, int fq) const {
        const int cb = u.pn * BM + wc * 64;
        int kind = 0; float sc = 1.f; const float* g = qg;
        if (layer == 0) {
            if (cb < Z0_KA) { kind = 1; g = qg; sc = C2_64; }
            else if (cb < Z0_VA) { kind = 1; g = kg; sc = 1.f; }
            else if (cb < Z0_QB) kind = 0;
            else if (cb < Z0_KB) { kind = 2; sc = C2_64; }
            else if (cb < Z0_QM) kind = 0;
            else if (cb < Z0_G) { kind = 2; sc = C2_128; }
            else kind = 3;
        } else {
            if (cb < Z1_KC) { kind = 2; sc = C2_64; }
            else if (cb < Z1_QM) kind = 0;
            else if (cb < Z1_G) { kind = 2; sc = C2_128; }
            else kind = 3;
        }
#pragma unroll
        for (int ai = 0; ai < 2; ++ai)
#pragma unroll
            for (int m = 0; m < 4; ++m) {
                const int row = u.pm * BM + ai * HALF + wr * 64 + m * 16 + fr;
                const f32x4* sp = (const f32x4*)(ssq + (size_t)row * 16);
                const f32x4 s0 = sp[0], s1 = sp[1], s2 = sp[2], s3 = sp[3];
                const float tot = (((s0[0] + s0[1]) + (s0[2] + s0[3])) + ((s1[0] + s1[1]) + (s1[2] + s1[3]))) + (((s2[0] + s2[1]) + (s2[2] + s2[3])) + ((s3[0] + s3[1]) + (s3[2] + s3[3])));
                const float rstd = __builtin_amdgcn_rsqf(tot * (1.0f / DM) + EPSN);
                f32x4 v[2][2];
#pragma unroll
                for (int bj = 0; bj < 2; ++bj)
#pragma unroll
                    for (int n = 0; n < 2; ++n) v[bj][n] = acc[ai][bj][m][n] * rstd;
                if (kind == 1) {
                    float ss = 0.f;
#pragma unroll
                    for (int bj = 0; bj < 2; ++bj)
#pragma unroll
                        for (int n = 0; n < 2; ++n) ss += (v[bj][n][0] * v[bj][n][0] + v[bj][n][1] * v[bj][n][1]) + (v[bj][n][2] * v[bj][n][2] + v[bj][n][3] * v[bj][n][3]);
                    ss += __shfl_xor(ss, 16); ss += __shfl_xor(ss, 32);
                    const float hr = __builtin_amdgcn_rsqf(ss * (1.0f / 64.0f) + EPSN);
#pragma unroll
                    for (int bj = 0; bj < 2; ++bj)
#pragma unroll
                        for (int n = 0; n < 2; ++n) { const f32x4 gv = *(const f32x4*)(g + 32 * bj + 16 * n + 4 * fq); v[bj][n] = v[bj][n] * hr * gv; }
                    const int pos = row & (SEQ - 1);
#pragma unroll
                    for (int bj = 0; bj < 2; ++bj) {
                        const int p = bj == 0 ? (pos >> 6) : (pos & 63);
                        const f32x4 cs = *(const f32x4*)(tab + TAB_COS + p * 16 + 4 * fq), sn = *(const f32x4*)(tab + TAB_SIN + p * 16 + 4 * fq);
                        const f32x4 x1 = v[bj][0], x2 = v[bj][1];
                        v[bj][0] = (x1 * cs - x2 * sn) * sc; v[bj][1] = (x1 * sn + x2 * cs) * sc;
                    }
                } else if (kind == 2) {
#pragma unroll
                    for (int bj = 0; bj < 2; ++bj)
#pragma unroll
                        for (int n = 0; n < 2; ++n) v[bj][n] = v[bj][n] * sc;
                } else if (kind == 3) {
#pragma unroll
                    for (int bj = 0; bj < 2; ++bj)
#pragma unroll
                        for (int n = 0; n < 2; ++n)
#pragma unroll
                            for (int j = 0; j < 4; ++j) { const float x = v[bj][n][j]; v[bj][n][j] = x * __builtin_amdgcn_rcpf(1.0f + __builtin_amdgcn_exp2f(-LOG2E * x)); }
                }
                bf16_t* zp = Z + (size_t)row * ldz + cb + 4 * fq;
#pragma unroll
                for (int bj = 0; bj < 2; ++bj)
#pragma unroll
                    for (int n = 0; n < 2; ++n) { u32x2 w; w.x = pk2(v[bj][n][0], v[bj][n][1]); w.y = pk2(v[bj][n][2], v[bj][n][3]); *(u32x2*)(zp + 32 * bj + 16 * n) = w; }
            }
    }
};
struct EpiPlain {
    bf16_t* O; int ldc;
    __device__ __forceinline__ void operator()(const f32x4 (&acc)[2][2][4][2], const Unit& u, int wr, int wc, int fr, int fq) const {
#pragma unroll
        for (int ai = 0; ai < 2; ++ai)
#pragma unroll
            for (int m = 0; m < 4; ++m) {
                const int row = u.pm * BM + ai * HALF + wr * 64 + m * 16 + fr;
                bf16_t* op = O + (size_t)row * ldc + u.pn * BM + wc * 32 + 4 * fq;
#pragma unroll
                for (int bj = 0; bj < 2; ++bj)
#pragma unroll
                    for (int n = 0; n < 2; ++n) { const f32x4 x = acc[ai][bj][m][n]; u32x2 w; w.x = pk2(x[0], x[1]); w.y = pk2(x[2], x[3]); *(u32x2*)(op + bj * HALF + 16 * n) = w; }
            }
    }
};
struct EpiOut {
    const float* resid; float* xo; bf16_t* xb; float* ssq;
    __device__ __forceinline__ void operator()(const f32x4 (&acc)[2][2][4][2], const Unit& u, int wr, int wc, int fr, int fq) const {
#pragma unroll
        for (int ai = 0; ai < 2; ++ai)
#pragma unroll
            for (int m = 0; m < 4; ++m) {
                const int row = u.pm * BM + ai * HALF + wr * 64 + m * 16 + fr;
                const size_t off = (size_t)row * DM + u.pn * BM + wc * 32 + 4 * fq;
                float ss = 0.f;
#pragma unroll
                for (int bj = 0; bj < 2; ++bj)
#pragma unroll
                    for (int n = 0; n < 2; ++n) {
                        const f32x4 r = *(const f32x4*)(resid + off + bj * HALF + 16 * n);
                        const f32x4 x = acc[ai][bj][m][n] + r;
                        *(f32x4*)(xo + off + bj * HALF + 16 * n) = x;
                        u32x2 w; w.x = pk2(x[0], x[1]); w.y = pk2(x[2], x[3]); *(u32x2*)(xb + off + bj * HALF + 16 * n) = w;
                        ss += (x[0] * x[0] + x[1] * x[1]) + (x[2] * x[2] + x[3] * x[3]);
                    }
                ss += __shfl_xor(ss, 16); ss += __shfl_xor(ss, 32);
                if (fq == 0) ssq[(size_t)row * 16 + u.pn * 4 + wc] = ss;
            }
    }
};
}

namespace sa {
typedef LAS const char* lds_cptr;
#define SBAR() __builtin_amdgcn_sched_barrier(0)
DEV int crow(int r, int hi) { return (r & 3) + 8 * (r >> 2) + 4 * hi; }
DEV void glds16(const void* gsrc, unsigned lds_dst) { unsigned keep;
    asm volatile("s_mov_b32 %0, m0\n\ts_mov_b32 m0, %2\n\ts_nop 0\n\tglobal_load_lds_dwordx4 %1, off\n\ts_mov_b32 m0, %0" : "=&s"(keep) : "v"(gsrc), "s"(lds_dst) : "memory"); }
DEV unsigned cvtpk_s(float lo, float hi) { f32x2_t v = {lo, hi}; bf16x2_t b = __builtin_convertvector(v, bf16x2_t); return __builtin_bit_cast(unsigned, b); }
DEV float rowmax(const f32x16& p0, const f32x16& p1) {
    float a = fmaxf(p0[0], p1[0]);
#pragma unroll
    for (int r = 1; r < 16; ++r) a = fmaxf(a, fmaxf(p0[r], p1[r]));
    auto rr = __builtin_amdgcn_permlane32_swap(__float_as_uint(a), __float_as_uint(a), false, false);
    return fmaxf(__uint_as_float(rr[0]), __uint_as_float(rr[1]));
}
constexpr int OFF_K = 0, OFF_WS = 65536, OFF_OST = 0;
constexpr float NEG_INF = -__builtin_huge_valf();

template <int D, class F>
__device__ __forceinline__ void unit(char* shm, const bf16_t* Qw, int qpitch, const bf16_t* Kt, const bf16_t* Vt, int kvpitch, int nt, const F& f, bf16_t* Ow, int opitch, bool do_store = true) {
    constexpr int SLOT = 64 * D * 2, ND0 = D / 16, NDB = D / 32, NP = D / 64, OFF_V = 2 * SLOT;
    constexpr float THR = 8.0f;
    const int tid = threadIdx.x, lane = tid & 63, r32 = lane & 31, hi = lane >> 5; const int wid = __builtin_amdgcn_readfirstlane(tid >> 6);
    const unsigned lds0 = (unsigned)(uintptr_t)shm;
    const lds_cptr shm3 = (lds_cptr)shm;
    LAS float* wsf = (LAS float*)(shm3 + OFF_WS) + wid * 64;
#define SA_DMA_TILE(j, slotoff) do { const long trow_ = f.tile_row(j); \
    _Pragma("unroll") for (int p_ = 0; p_ < NP; ++p_) { const int c_ = wid + 8 * p_; glds16(Kt + (trow_ + lane) * (long)kvpitch + c_ * 8, (unsigned)__builtin_amdgcn_readfirstlane(lds0 + OFF_K + (slotoff) + c_ * 1024)); } \
    _Pragma("unroll") for (int p_ = 0; p_ < NP; ++p_) { const int bi_ = wid + 8 * p_; glds16(Vt + (trow_ + 16 * (bi_ & 3) + (lane >> 2)) * (long)kvpitch + (bi_ >> 2) * 32 + (lane & 3) * 8, (unsigned)__builtin_amdgcn_readfirstlane(lds0 + OFF_V + (slotoff) + bi_ * 1024)); } } while (0)
    SA_DMA_TILE(0, 0);
    bf16x8 qr[ND0];
#pragma unroll
    for (int d0 = 0; d0 < ND0; ++d0) qr[d0] = *reinterpret_cast<const bf16x8*>(&Qw[(long)r32 * qpitch + d0 * 16 + hi * 8]);
    float mhat = F::has_init ? f.init_m() : 0.f, l_reg = (F::has_init && hi == 0) ? 1.f : 0.f;
    bool started = F::has_init;
    f32x16 o[NDB];
#pragma unroll
    for (int d = 0; d < NDB; ++d) o[d] = f32x16{};
    f32x16 negm;
#pragma unroll
    for (int r = 0; r < 16; ++r) negm[r] = -mhat;
    const int vb0 = (int)(lds0 + OFF_V) + ((lane >> 4) & 1) * 32 + (lane & 3) * 8 + (4 * hi + ((lane & 15) >> 2)) * 64;
    for (int j = 0; j < nt; ++j) {
        const int so = (j & 1) * SLOT;
        if (j + 1 < nt) {
            SA_DMA_TILE(j + 1, ((j + 1) & 1) * SLOT);
            if constexpr (NP == 1) asm volatile("s_waitcnt vmcnt(2) lgkmcnt(0)\n\ts_barrier" ::: "memory");
            else asm volatile("s_waitcnt vmcnt(4) lgkmcnt(0)\n\ts_barrier" ::: "memory");
        } else asm volatile("s_waitcnt vmcnt(0) lgkmcnt(0)\n\ts_barrier" ::: "memory");
        if (f.active(j)) {
            const lds_cptr kp = shm3 + OFF_K + so + hi * 1024 + r32 * 16;
            f32x16 p0, p1;
#pragma unroll
            for (int d0 = 0; d0 < ND0; ++d0) {
                const bf16x8 b0 = *(const LAS bf16x8*)(kp + d0 * 2048), b1 = *(const LAS bf16x8*)(kp + d0 * 2048 + 512);
                if (d0 == 0) { p0 = __builtin_amdgcn_mfma_f32_32x32x16_bf16(b0, qr[0], negm, 0, 0, 0); p1 = __builtin_amdgcn_mfma_f32_32x32x16_bf16(b1, qr[0], negm, 0, 0, 0); }
                else { p0 = __builtin_amdgcn_mfma_f32_32x32x16_bf16(b0, qr[d0], p0, 0, 0, 0); p1 = __builtin_amdgcn_mfma_f32_32x32x16_bf16(b1, qr[d0], p1, 0, 0, 0); }
            }
            f.apply(p0, p1, j);
            const float rm = rowmax(p0, p1);
            if (!started) {
                const float dl = (rm == NEG_INF) ? 0.f : rm;
                mhat = dl;
#pragma unroll
                for (int r = 0; r < 16; ++r) { p0[r] -= dl; p1[r] -= dl; negm[r] = -mhat; }
                started = true;
            } else if (__any(rm > THR)) {
                const float dl = fmaxf(rm, 0.f); mhat += dl;
#pragma unroll
                for (int r = 0; r < 16; ++r) { p0[r] -= dl; p1[r] -= dl; negm[r] = -mhat; }
                const float fs = __builtin_amdgcn_exp2f(-dl); l_reg *= fs;
                if (hi == 0) wsf[r32] = fs;
                asm volatile("s_waitcnt lgkmcnt(0)" ::: "memory");
#pragma unroll
                for (int r = 0; r < 16; ++r) { const float fr_ = wsf[crow(r, hi)];
#pragma unroll
                    for (int d = 0; d < NDB; ++d) o[d][r] *= fr_; }
            }
            float sacc = 0.f;
#pragma unroll
            for (int r = 0; r < 16; ++r) { p0[r] = __builtin_amdgcn_exp2f(p0[r]); p1[r] = __builtin_amdgcn_exp2f(p1[r]); sacc += p0[r] + p1[r]; }
            l_reg += sacc;
            u32x4 pw[4];
#pragma unroll
            for (int q = 0; q < 4; ++q) { pw[0][q] = cvtpk_s(p0[2 * q], p0[2 * q + 1]); pw[1][q] = cvtpk_s(p0[8 + 2 * q], p0[8 + 2 * q + 1]); pw[2][q] = cvtpk_s(p1[2 * q], p1[2 * q + 1]); pw[3][q] = cvtpk_s(p1[8 + 2 * q], p1[8 + 2 * q + 1]); }
            const int vb = vb0 + so;
#pragma unroll
            for (int d0 = 0; d0 < NDB; ++d0) { s16x4 lo[4], hv[4];
#pragma unroll
                for (int ks = 0; ks < 4; ++ks) {
                    asm volatile("ds_read_b64_tr_b16 %0,%1 offset:%c2" : "=&v"(lo[ks]) : "v"(vb), "i"(d0 * 4096 + ks * 1024) : "memory");
                    asm volatile("ds_read_b64_tr_b16 %0,%1 offset:%c2" : "=&v"(hv[ks]) : "v"(vb), "i"(d0 * 4096 + ks * 1024 + 512) : "memory"); }
                asm volatile("s_waitcnt lgkmcnt(0)" ::: "memory"); SBAR();
#pragma unroll
                for (int ks = 0; ks < 4; ++ks) { const bf16x8 vf = (bf16x8){lo[ks][0], lo[ks][1], lo[ks][2], lo[ks][3], hv[ks][0], hv[ks][1], hv[ks][2], hv[ks][3]};
                    o[d0] = __builtin_amdgcn_mfma_f32_32x32x16_bf16(__builtin_bit_cast(bf16x8, pw[ks]), vf, o[d0], 0, 0, 0); }
            }
        }
        asm volatile("s_waitcnt lgkmcnt(0)\n\ts_barrier" ::: "memory");
    }
#undef SA_DMA_TILE
    { auto rr = __builtin_amdgcn_permlane32_swap(__float_as_uint(l_reg), __float_as_uint(l_reg), false, false); l_reg = __uint_as_float(rr[0]) + __uint_as_float(rr[1]); }
    if (hi == 0) wsf[32 + r32] = l_reg;
    asm volatile("s_waitcnt lgkmcnt(0)" ::: "memory");
    LAS bf16_t* stg = (LAS bf16_t*)(shm3 + OFF_OST) + wid * (32 * D);
#pragma unroll
    for (int r = 0; r < 16; ++r) { const int orow = crow(r, hi); const float rli = 1.0f / wsf[32 + orow];
#pragma unroll
        for (int d0 = 0; d0 < NDB; ++d0) stg[orow * D + d0 * 32 + r32] = (bf16_t)f2bf(o[d0][r] * rli); }
    asm volatile("s_waitcnt lgkmcnt(0)" ::: "memory");
    constexpr int CPR = D / 8, NIT = (32 * CPR) / 64;
#pragma unroll
    for (int i = 0; i < NIT; ++i) { const int idx = i * 64 + lane, row = idx / CPR, ch = idx % CPR;
        const u32x4 ov = *(const LAS u32x4*)(stg + row * D + ch * 8);
        bf16_t* gp = Ow + (long)row * opitch + ch * 8;
        const u32x4 gv = *(const u32x4*)gp; u32x4 w;
#pragma unroll
        for (int q = 0; q < 4; ++q) w[q] = pk2(bflo(ov[q]) * bflo(gv[q]), bfhi(ov[q]) * bfhi(gv[q]));
        if (do_store) *(u32x4*)gp = w; }
    asm volatile("s_waitcnt lgkmcnt(0)\n\ts_barrier" ::: "memory");
}
#undef SBAR

struct FDense {
    static constexpr bool has_init = false;
    DEV long tile_row(int j) const { return 64L * j; }
    DEV bool active(int) const { return true; }
    DEV float init_m() const { return 0.f; }
    DEV void apply(f32x16&, f32x16&, int) const {}
};
struct FWindow {
    static constexpr bool has_init = true;
    int t_lo; int qpos0; float sink_l2; LAS const float* tab; int r32, hi;
    DEV long tile_row(int j) const { return t_lo + 64L * j; }
    DEV bool active(int) const { return true; }
    DEV float init_m() const { return sink_l2; }
    DEV void apply(f32x16& p0, f32x16& p1, int j) const {
        LAS const float* tp = tab + (t_lo + 64 * j - qpos0 - r32 + 191 + 4 * hi);
#pragma unroll
        for (int r = 0; r < 16; ++r) { const int o = (r & 3) + 8 * (r >> 2); p0[r] += tp[o]; p1[r] += tp[32 + o]; }
    }
};
struct FNeigh {
    static constexpr bool has_init = false;
    int kr_lo, rq, rs, cq, cs; LAS const float* rpbh; int hi;
    DEV long tile_row(int j) const { return 64L * (kr_lo + j); }
    DEV bool active(int j) const { const int kr = kr_lo + j; return kr >= rs && kr <= rs + 7; }
    DEV float init_m() const { return 0.f; }
    DEV void apply(f32x16& p0, f32x16& p1, int j) const {
        const int dr = kr_lo + j - rq + 7; LAS const float* tp = rpbh + dr * 32;
#pragma unroll
        for (int r = 0; r < 16; ++r) { const int kc = (r & 3) + 8 * (r >> 2) + 4 * hi;
            { const int dc = kc - cq + 15; const bool ok = (unsigned)(kc - cs) < 16u; const float b = tp[dc & 31]; p0[r] = ok ? p0[r] + b : NEG_INF; }
            { const int k2 = kc + 32; const int dc = k2 - cq + 15; const bool ok = (unsigned)(k2 - cs) < 16u; const float b = tp[dc & 31]; p1[r] = ok ? p1[r] + b : NEG_INF; } }
    }
};
}


#define GAS __attribute__((address_space(1)))
#define XB_TMO      128
#define XB_XCNT(j)  (256  + 64 * (j))
#define XB_XSUB(j)  (1280 + 64 * (j))
#define XB_XGEN(j)  (2304 + 64 * (j))
#define XB_TOP      3328
#define XB_TOPGEN   3392
#define XCD_BAR_WORDS 3456
#define XB_SPIN_CAP (1u << 18)
__device__ __forceinline__ unsigned xb_ld(unsigned* p)              { return __hip_atomic_load(p, __ATOMIC_RELAXED, __HIP_MEMORY_SCOPE_AGENT); }
__device__ __forceinline__ unsigned xb_add(unsigned* p, unsigned v) { return __hip_atomic_fetch_add(p, v, __ATOMIC_RELAXED, __HIP_MEMORY_SCOPE_AGENT); }
__device__ __forceinline__ unsigned xb_xcc_id() { return (unsigned)__builtin_amdgcn_s_getreg((3 << 11) | 20) & 0xFu; }
#define XB_SPIN(cond, bar) do { unsigned _sp = 0; while (cond) { __builtin_amdgcn_s_sleep(1); \
    if ((++_sp & 255u) == 0u) { if (xb_ld(&(bar)[XB_TMO])) break; if (_sp > XB_SPIN_CAP) { atomicAdd(&(bar)[XB_TMO], 1u); break; } } } } while (0)
struct XcdBarrier { unsigned* bar; unsigned x; volatile LAS unsigned* st; };
__device__ __forceinline__ XcdBarrier xcd_barrier_post(unsigned* bar, volatile LAS unsigned* st) {
    XcdBarrier b; b.bar = bar; b.x = xb_xcc_id(); b.st = st;
    if (threadIdx.x == 0) (void)xb_add(&bar[XB_XCNT(b.x)], 1u);
    return b;
}
__device__ __forceinline__ void xcd_barrier_complete(unsigned* bar, unsigned x, unsigned& nloc, unsigned& nx) {
    const unsigned G = gridDim.x * gridDim.y * gridDim.z;
    unsigned sum, cnt, mine, sp = 0u;
    for (;;) {
        sum = 0u; cnt = 0u; mine = 0u;
#pragma unroll
        for (unsigned j = 0; j < 16; ++j) { const unsigned c = xb_ld(&bar[XB_XCNT(j)]); sum += c; cnt += (c > 0u) ? 1u : 0u; mine = (j == x) ? c : mine; }
        if (sum == G) break;
        __builtin_amdgcn_s_sleep(1);
        if ((++sp & 255u) == 0u) { if (xb_ld(&bar[XB_TMO])) break; if (sp > XB_SPIN_CAP) { atomicAdd(&bar[XB_TMO], 1u); break; } }
    }
    nloc = mine > 0u ? mine : 1u; nx = cnt > 0u ? cnt : 1u;
}
__device__ __forceinline__ void xcd_barrier(const XcdBarrier& b) {
    asm volatile("s_waitcnt vmcnt(0)" ::: "memory");
    __syncthreads();
    if (threadIdx.x == 0) {
        unsigned* bar = b.bar;
        __builtin_amdgcn_s_waitcnt(0);
        unsigned nloc = b.st[0], nx = b.st[1];
        if (nloc == 0u) { xcd_barrier_complete(bar, b.x, nloc, nx); b.st[0] = nloc; b.st[1] = nx; }
        const unsigned old = xb_add(&bar[XB_XSUB(b.x)], 1u);
        const unsigned gen = old / nloc;
        if (old + 1u == (gen + 1u) * nloc) {
            __builtin_amdgcn_fence(__ATOMIC_RELEASE, "agent");
            asm volatile("s_waitcnt vmcnt(0)" ::: "memory");
            const unsigned og = xb_add(&bar[XB_TOP], 1u);
            const unsigned tg = og / nx;
            if (og + 1u == (tg + 1u) * nx) xb_add(&bar[XB_TOPGEN], 1u);
            else XB_SPIN(xb_ld(&bar[XB_TOPGEN]) == tg, bar);
            __builtin_amdgcn_fence(__ATOMIC_ACQUIRE, "agent");
            xb_add(&bar[XB_XGEN(b.x)], 1u);
            asm volatile("s_waitcnt vmcnt(0)" ::: "memory");
        } else {
            XB_SPIN(xb_ld(&bar[XB_XGEN(b.x)]) == gen, bar);
            __builtin_amdgcn_fence(__ATOMIC_ACQUIRE, "agent");
            asm volatile("s_waitcnt vmcnt(0)" ::: "memory");
        }
    }
    __syncthreads();
}
constexpr int NWAVES = 8;
#ifndef PROBE_REP
#define PROBE_REP 0
#endif
struct Args { const float* in[15]; float* out; unsigned char* ws; int ph_lo, ph_hi; };

DEV void transpose_item(const float* W, int N, int K, bf16_t* WT, int k0, int n0, int dst_row0, const float* gain, LAS float* scr, int lane) {
#pragma unroll 8
    for (int i = 0; i < 32; ++i) { const int kk = 2 * i + (lane >> 5); scr[kk * 33 + (lane & 31)] = W[(size_t)(k0 + kk) * N + n0 + (lane & 31)]; }
    asm volatile("s_waitcnt lgkmcnt(0)" ::: "memory");
    const int c = lane & 7;
    float gk[8];
#pragma unroll
    for (int i = 0; i < 8; ++i) gk[i] = gain ? gain[k0 + 8 * c + i] : 1.0f;
#pragma unroll
    for (int j = 0; j < 4; ++j) { const int n = (lane >> 3) + 8 * j; const LAS float* s = scr + (8 * c) * 33 + n;
        u32x4 o; o.x = pk2(s[0 * 33] * gk[0], s[1 * 33] * gk[1]); o.y = pk2(s[2 * 33] * gk[2], s[3 * 33] * gk[3]); o.z = pk2(s[4 * 33] * gk[4], s[5 * 33] * gk[5]); o.w = pk2(s[6 * 33] * gk[6], s[7 * 33] * gk[7]);
        *(u32x4*)(WT + (size_t)(dst_row0 + n) * K + k0 + 8 * c) = o; }
    asm volatile("s_waitcnt lgkmcnt(0)" ::: "memory");
}
DEV int perm_row0(int n0) { const int t = n0 >> 8, gl = (n0 & 255) >> 5, wc = gl >> 1, bj = gl & 1; return (t << 8) + 32 * (4 * bj + wc); }

DEV int t5_bucket(int rel) {
    const int n = rel < 0 ? -rel : rel; int b = rel > 0 ? 16 : 0;
    if (n < 8) return b + n;
    int large = 2 + (31 - __clz(n * n)); if (large > 15) large = 15;
    return b + large;
}

__global__ void __launch_bounds__(NWAVES * 64, 2) fwd_kernel(Args args) {
    extern __shared__ __attribute__((aligned(16))) unsigned char lds[];
    const int tid = threadIdx.x, lane = tid & 63, wave = __builtin_amdgcn_readfirstlane(tid >> 6);
    const int G = gridDim.x; const int bx = blockIdx.x; const int vcu = (G % 8 == 0) ? (bx % 8) * (G / 8) + bx / 8 : bx;
    unsigned char* ws = args.ws;
    const float* x = args.in[0]; const float* mem = args.in[1]; const float* norm_gain = args.in[2]; const float* mem_gain = args.in[3];
    const float* w_in0 = args.in[4]; const float* w_out0 = args.in[5]; const float* q_norm = args.in[6]; const float* k_norm = args.in[7];
    const float* sink_b = args.in[8]; const float* rel_bias = args.in[9]; const float* w_in1 = args.in[10]; const float* w_out1 = args.in[11];
    const float* rpb_c = args.in[12]; const float* w_mkv = args.in[13]; const float* fin_gain = args.in[14];
    float* out = args.out;
    float* tab = (float*)(ws + WS_TAB);
    bf16_t* WIN0 = (bf16_t*)(ws + WS_WIN0); bf16_t* WIN1 = (bf16_t*)(ws + WS_WIN1); bf16_t* WOUT0 = (bf16_t*)(ws + WS_WOUT0); bf16_t* WOUT1 = (bf16_t*)(ws + WS_WOUT1);
    bf16_t* WMKV = (bf16_t*)(ws + WS_WMKV); bf16_t* MEMN = (bf16_t*)(ws + WS_MEMN); bf16_t* MKV = (bf16_t*)(ws + WS_MKV);
    float* SSQ0 = (float*)(ws + WS_SSQ0); float* SSQ1 = (float*)(ws + WS_SSQ1); float* SSQ2 = (float*)(ws + WS_SSQ2);
    bf16_t* XB = (bf16_t*)(ws + WS_XB); bf16_t* Z = (bf16_t*)(ws + WS_Z);
    LAS unsigned char* ldsl = (LAS unsigned char*)lds;
    const int lo = args.ph_lo, hi_ph = args.ph_hi;
    volatile LAS unsigned* MISC = (volatile LAS unsigned*)(ldsl + LDS_MISC_OFF);
    if (tid < 32) MISC[tid] = 0u;
    __syncthreads();
    XcdBarrier bar = xcd_barrier_post((unsigned*)(ws + WS_CTL) + CW_BAR, MISC + 8);
#define IN(k) (lo <= (k) && (k) < hi_ph)
#define SEAM(k) do { if (IN(k) && IN((k) + 1)) xcd_barrier(bar); } while (0)
    const int gw = vcu * NWAVES + wave, NGW = G * NWAVES;

    if (IN(0)) {
        LAS float* scr = (LAS float*)(ldsl + wave * 16384);
        constexpr int I_IN0 = (DM / 64) * (IN0 / 32), I_IN1 = (DM / 64) * (IN1 / 32), I_OUT = (MIX / 64) * (DM / 32), I_MKV = (DM / 64) * (DM / 32);
        constexpr int NITEMS = I_IN0 + I_IN1 + 2 * I_OUT + 2 * I_MKV;
        for (int it = gw; it < NITEMS; it += NGW) {
            int r = it;
            if (r < I_IN0) { const int nblk = IN0 / 32, kb = r / nblk, nb = r % nblk; transpose_item(w_in0, IN0, DM, WIN0, 64 * kb, 32 * nb, perm_row0(32 * nb), norm_gain, scr, lane); continue; } r -= I_IN0;
            if (r < I_IN1) { const int nblk = IN1 / 32, kb = r / nblk, nb = r % nblk; transpose_item(w_in1, IN1, DM, WIN1, 64 * kb, 32 * nb, perm_row0(32 * nb), norm_gain + DM, scr, lane); continue; } r -= I_IN1;
            if (r < I_OUT) { const int nblk = DM / 32, kb = r / nblk, nb = r % nblk; transpose_item(w_out0, DM, MIX, WOUT0, 64 * kb, 32 * nb, 32 * nb, nullptr, scr, lane); continue; } r -= I_OUT;
            if (r < I_OUT) { const int nblk = DM / 32, kb = r / nblk, nb = r % nblk; transpose_item(w_out1, DM, MIX, WOUT1, 64 * kb, 32 * nb, 32 * nb, nullptr, scr, lane); continue; } r -= I_OUT;
            { const int l = r / I_MKV; r -= l * I_MKV; const int nblk = DM / 32, kb = r / nblk, nb = r % nblk;
              transpose_item(w_mkv + (size_t)l * DM * DM, DM, DM, WMKV, 64 * kb, 32 * nb, l * DM + 32 * nb, nullptr, scr, lane); }
        }
        for (int m = gw; m < MTOK; m += NGW) {
            const f32x4* xr = (const f32x4*)(x + (size_t)m * DM) + lane; f32x4 v[4]; float s = 0.f;
#pragma unroll
            for (int j = 0; j < 4; ++j) { v[j] = xr[64 * j]; s += (v[j][0] * v[j][0] + v[j][1] * v[j][1]) + (v[j][2] * v[j][2] + v[j][3] * v[j][3]); }
            s = wave_sum(s);
            u32x2* o8 = (u32x2*)(XB + (size_t)m * DM) + lane;
#pragma unroll
            for (int j = 0; j < 4; ++j) { u32x2 w; w.x = pk2(v[j][0], v[j][1]); w.y = pk2(v[j][2], v[j][3]); o8[64 * j] = w; }
            if (lane < 16) SSQ0[(size_t)m * 16 + lane] = lane == 0 ? s : 0.f;
        }
        for (int m = gw; m < NB * MEML; m += NGW) {
            const f32x4* xr = (const f32x4*)(mem + (size_t)m * DM) + lane; const f32x4* gr = (const f32x4*)mem_gain + lane; f32x4 v[4]; float s = 0.f;
#pragma unroll
            for (int j = 0; j < 4; ++j) { v[j] = xr[64 * j]; s += (v[j][0] * v[j][0] + v[j][1] * v[j][1]) + (v[j][2] * v[j][2] + v[j][3] * v[j][3]); }
            s = wave_sum(s); const float rstd = 1.0f / sqrtf(s * (1.0f / DM) + EPSN);
            u32x2* o8 = (u32x2*)(MEMN + (size_t)m * DM) + lane;
#pragma unroll
            for (int j = 0; j < 4; ++j) { const f32x4 g4 = gr[64 * j]; const f32x4 y = v[j] * rstd * g4; u32x2 w; w.x = pk2(y[0], y[1]); w.y = pk2(y[2], y[3]); o8[64 * j] = w; }
        }
        if (bx == 0) {
            for (int i = tid; i < 1024; i += NWAVES * 64) { const int p = i >> 4, k = i & 15;
                const float fr = (float)pow(10000.0, -(double)k / 16.0); const float ang = (float)p * fr;
                tab[TAB_COS + i] = (float)cos((double)ang); tab[TAB_SIN + i] = (float)sin((double)ang); }
            for (int i = tid; i < 8 * 384; i += NWAVES * 64) { const int h = i / 384, e = i % 384; const int rel = e - 191;
                float v = -__builtin_huge_valf();
                if (rel >= -128 && rel <= 128) v = rel_bias[t5_bucket(rel) * 8 + h] * LOG2E;
                tab[TAB_BIASB + i] = v; }
            for (int i = tid; i < 16 * 15 * 32; i += NWAVES * 64) { const int dc = i & 31, hd = i >> 5;
                tab[TAB_RPB + i] = dc < 31 ? rpb_c[hd * 31 + dc] * LOG2E : 0.f; }
        }
    }
    SEAM(0);

#if PROBE_REP & 2
    if (IN(1)) {
        { pg8::Gemm g{XB, WIN0, MTOK, IN0, DM, DM}; pg8::StaticOrder S; S.init(MTOK, IN0, G, bx);
          pg8::EpiIn E{Z, IN0, SSQ0, 0, q_norm, k_norm, tab};
          pg8::gemm_phase<pg8::EpiIn, pg8::StaticOrder, true>(ldsl, g, S, E); }
        { pg8::Gemm g{MEMN, WMKV, NB * MEML, 2 * DM, DM, DM}; pg8::StaticOrder S; S.init(NB * MEML, 2 * DM, G, bx);
          pg8::EpiPlain E{MKV, 2 * DM};
          pg8::gemm_phase<pg8::EpiPlain, pg8::StaticOrder, true>(ldsl, g, S, E); }
    }
#endif
    if (IN(1)) {
        { pg8::Gemm g{XB, WIN0, MTOK, IN0, DM, DM}; pg8::StaticOrder S; S.init(MTOK, IN0, G, bx);
          pg8::EpiIn E{Z, IN0, SSQ0, 0, q_norm, k_norm, tab};
          pg8::gemm_phase<pg8::EpiIn, pg8::StaticOrder, true>(ldsl, g, S, E); }
        { pg8::Gemm g{MEMN, WMKV, NB * MEML, 2 * DM, DM, DM}; pg8::StaticOrder S; S.init(NB * MEML, 2 * DM, G, bx);
          pg8::EpiPlain E{MKV, 2 * DM};
          pg8::gemm_phase<pg8::EpiPlain, pg8::StaticOrder, true>(ldsl, g, S, E); }
    }
    SEAM(1);

    if (IN(2)) {
        LAS float* ltab = (LAS float*)(ldsl + LDS_TAB_OFF);
        for (int i = tid; i < 8 * 384; i += NWAVES * 64) ltab[i] = tab[TAB_BIASB + i];
        __syncthreads();
        const int r32 = lane & 31, hi = lane >> 5;
        { constexpr int NU = NB * 8 * 16; const int per = (NU + G - 1) / G;
          for (int rep_ = 0; rep_ < ((PROBE_REP & 4) ? 2 : 1); ++rep_) { const bool st_ = (rep_ == ((PROBE_REP & 4) ? 1 : 0)) || args.ph_hi > 100;
          for (int uid = vcu * per; uid < NU && uid < (vcu + 1) * per; ++uid) {
              const int qb = uid & 15, h = (uid >> 4) & 7, b = uid >> 7, kvh = h >> 2;
              const size_t rowb = (size_t)b * SEQ;
              const bf16_t* Qw = Z + (rowb + qb * 256 + wave * 32) * IN0 + Z0_QA + h * 64;
              sa::FDense f;
              sa::unit<64, sa::FDense>((char*)lds, Qw, IN0, Z + rowb * IN0 + Z0_KA + kvh * 64, Z + rowb * IN0 + Z0_VA + kvh * 64, IN0, SEQ / 64, f,
                                       Z + (rowb + qb * 256 + wave * 32) * IN0 + Z0_G + h * 64, IN0, st_);
          } } }
        { constexpr int NU = NB * 2 * 64; const int per = (NU + G - 1) / G;
          for (int rep_ = 0; rep_ < ((PROBE_REP & 8) ? 2 : 1); ++rep_) { const bool st_ = (rep_ == ((PROBE_REP & 8) ? 1 : 0)) || args.ph_hi > 100;
          for (int uid = vcu * per; uid < NU && uid < (vcu + 1) * per; ++uid) {
              const int qc = uid & 63, kvh = (uid >> 6) & 1, b = uid >> 7; const int q0 = qc * 64, h = kvh * 4 + (wave >> 1);
              const size_t rowb = (size_t)b * SEQ; const int qpos0 = q0 + 32 * (wave & 1);
              const int t_lo = q0 - 128 < 0 ? 0 : q0 - 128, t_hi = q0 + 192 > SEQ ? SEQ : q0 + 192;
              sa::FWindow f{t_lo, qpos0, sink_b[h] * LOG2E, ltab + h * 384, r32, hi};
              sa::unit<64, sa::FWindow>((char*)lds, Z + (rowb + qpos0) * IN0 + Z0_QB + h * 64, IN0, Z + rowb * IN0 + Z0_KB + kvh * 64, Z + rowb * IN0 + Z0_VB + kvh * 64, IN0, (t_hi - t_lo) / 64, f,
                                        Z + (rowb + qpos0) * IN0 + Z0_G + 512 + h * 64, IN0, st_);
          } } }
        { constexpr int NU = NB * 4 * 16; const int per = (NU + G - 1) / G;
          for (int rep_ = 0; rep_ < ((PROBE_REP & 16) ? 2 : 1); ++rep_) { const bool st_ = (rep_ == ((PROBE_REP & 16) ? 1 : 0)) || args.ph_hi > 100;
          for (int uid = vcu * per; uid < NU && uid < (vcu + 1) * per; ++uid) {
              const int qb = uid & 15, hm = (uid >> 4) & 3, b = uid >> 6; const size_t rowb = (size_t)b * SEQ;
              sa::FDense f;
              sa::unit<128, sa::FDense>((char*)lds, Z + (rowb + qb * 256 + wave * 32) * IN0 + Z0_QM + hm * 128, IN0, MKV + (size_t)b * MEML * 2048 + hm * 128, MKV + (size_t)b * MEML * 2048 + 512 + hm * 128, 2048, MEML / 64, f,
                                        Z + (rowb + qb * 256 + wave * 32) * IN0 + Z0_G + 1024 + hm * 128, IN0, st_);
          } } }
    }
    SEAM(2);

#if PROBE_REP & 32
    if (IN(3)) {
        pg8::Gemm g{Z + Z0_G, WOUT0, MTOK, DM, MIX, IN0}; pg8::StaticOrder S; S.init(MTOK, DM, G, bx);
        pg8::EpiOut E{x, out, XB, SSQ1};
        pg8::gemm_phase<pg8::EpiOut, pg8::StaticOrder, true>(ldsl, g, S, E);
    }
#endif
    if (IN(3)) {
        pg8::Gemm g{Z + Z0_G, WOUT0, MTOK, DM, MIX, IN0}; pg8::StaticOrder S; S.init(MTOK, DM, G, bx);
        pg8::EpiOut E{x, out, XB, SSQ1};
        pg8::gemm_phase<pg8::EpiOut, pg8::StaticOrder, true>(ldsl, g, S, E);
    }
    SEAM(3);

#if PROBE_REP & 64
    if (IN(4)) {
        pg8::Gemm g{XB, WIN1, MTOK, IN1, DM, DM}; pg8::StaticOrder S; S.init(MTOK, IN1, G, bx);
        pg8::EpiIn E{Z, IN1, SSQ1, 1, q_norm, k_norm, tab};
        pg8::gemm_phase<pg8::EpiIn, pg8::StaticOrder, true>(ldsl, g, S, E);
    }
#endif
    if (IN(4)) {
        pg8::Gemm g{XB, WIN1, MTOK, IN1, DM, DM}; pg8::StaticOrder S; S.init(MTOK, IN1, G, bx);
        pg8::EpiIn E{Z, IN1, SSQ1, 1, q_norm, k_norm, tab};
        pg8::gemm_phase<pg8::EpiIn, pg8::StaticOrder, true>(ldsl, g, S, E);
    }
    SEAM(4);

    if (IN(5)) {
        LAS float* ltab = (LAS float*)(ldsl + LDS_TAB_OFF);
        for (int i = tid; i < 16 * 15 * 32; i += NWAVES * 64) ltab[i] = tab[TAB_RPB + i];
        __syncthreads();
        const int r32 = lane & 31, hi = lane >> 5;
        { constexpr int NU = NB * 16 * 16; const int per = (NU + G - 1) / G;
          for (int rep_ = 0; rep_ < ((PROBE_REP & 128) ? 2 : 1); ++rep_) { const bool st_ = (rep_ == ((PROBE_REP & 128) ? 1 : 0)) || args.ph_hi > 100;
          for (int uid = vcu * per; uid < NU && uid < (vcu + 1) * per; ++uid) {
              const int rg = uid & 15, h = (uid >> 4) & 15, b = uid >> 8; const size_t rowb = (size_t)b * SEQ;
              const int r0 = 4 * rg, rq = r0 + (wave >> 1), cq = 32 * (wave & 1) + r32;
              auto clip = [](int v, int a, int c) { return v < a ? a : (v > c ? c : v); };
              const int kr_lo = clip(r0 - 4, 0, 56), kr_hi = clip(r0 + 3 - 4, 0, 56) + 7;
              sa::FNeigh f{kr_lo, rq, clip(rq - 4, 0, 56), cq, clip(cq - 8, 0, 48), ltab + h * 15 * 32, hi};
              const size_t qrow = rowb + rq * 64 + 32 * (wave & 1);
              sa::unit<64, sa::FNeigh>((char*)lds, Z + qrow * IN1 + Z1_QC + h * 64, IN1, Z + rowb * IN1 + Z1_KC + h * 64, Z + rowb * IN1 + Z1_VC + h * 64, IN1, kr_hi - kr_lo + 1, f,
                                       Z + qrow * IN1 + Z1_G + h * 64, IN1, st_);
          } } }
        { constexpr int NU = NB * 4 * 16; const int per = (NU + G - 1) / G;
          for (int rep_ = 0; rep_ < ((PROBE_REP & 256) ? 2 : 1); ++rep_) { const bool st_ = (rep_ == ((PROBE_REP & 256) ? 1 : 0)) || args.ph_hi > 100;
          for (int uid = vcu * per; uid < NU && uid < (vcu + 1) * per; ++uid) {
              const int qb = uid & 15, hm = (uid >> 4) & 3, b = uid >> 6; const size_t rowb = (size_t)b * SEQ;
              sa::FDense f;
              sa::unit<128, sa::FDense>((char*)lds, Z + (rowb + qb * 256 + wave * 32) * IN1 + Z1_QM + hm * 128, IN1, MKV + (size_t)b * MEML * 2048 + 1024 + hm * 128, MKV + (size_t)b * MEML * 2048 + 1024 + 512 + hm * 128, 2048, MEML / 64, f,
                                        Z + (rowb + qb * 256 + wave * 32) * IN1 + Z1_G + 1024 + hm * 128, IN1, st_);
          } } }
    }
    SEAM(5);

    if (IN(6)) {
        pg8::Gemm g{Z + Z1_G, WOUT1, MTOK, DM, MIX, IN1}; pg8::StaticOrder S; S.init(MTOK, DM, G, bx);
        pg8::EpiOut E{out, out, XB, SSQ2};
        pg8::gemm_phase<pg8::EpiOut, pg8::StaticOrder, true>(ldsl, g, S, E);
    }
    SEAM(6);

    if (IN(7)) {
        for (int m = gw; m < MTOK; m += NGW) {
            f32x4* xr = (f32x4*)(out + (size_t)m * DM) + lane; const f32x4* gr = (const f32x4*)fin_gain + lane;
            float s = lane < 16 ? SSQ2[(size_t)m * 16 + lane] : 0.f; s = wave_sum(s);
            const float rstd = 1.0f / sqrtf(s * (1.0f / DM) + EPSN);
#pragma unroll
            for (int j = 0; j < 4; ++j) { const f32x4 v = xr[64 * j]; xr[64 * j] = v * rstd * gr[64 * j]; }
        }
    }
#undef IN
#undef SEAM
}

#ifndef MK_N_LAUNCHES
#define MK_N_LAUNCHES 1
#endif
extern "C" void kernel_launch(void* const* d_in, const int* in_sizes, int n_in, void* d_out, int out_size, void* d_ws, size_t ws_size, hipStream_t stream) {
    static int grid = 0;
    if (grid == 0) {
        if (n_in != 15 || out_size != MTOK * DM || ws_size < WS_END) { fprintf(stderr, "kernel_launch: unexpected shapes (n_in %d out %d ws %zu)\n", n_in, out_size, ws_size); grid = -1; return; }
        int dev = 0, cus = 0, per_cu = 0;
        hipGetDevice(&dev); hipDeviceGetAttribute(&cus, hipDeviceAttributeMultiprocessorCount, dev);
        hipFuncSetAttribute((const void*)fwd_kernel, hipFuncAttributeMaxDynamicSharedMemorySize, LDS_BYTES);
        hipOccupancyMaxActiveBlocksPerMultiprocessor(&per_cu, (const void*)fwd_kernel, NWAVES * 64, LDS_BYTES);
        (void)hipGetLastError();
        if (per_cu < 1) { fprintf(stderr, "kernel_launch: occupancy query says %d blocks per CU\n", per_cu); per_cu = 1; }
        grid = cus;
    }
    if (grid < 0) return;
    Args a{};
    for (int i = 0; i < 15; ++i) a.in[i] = (const float*)d_in[i];
    a.out = (float*)d_out; a.ws = (unsigned char*)d_ws;
    if (hipMemsetAsync((char*)d_ws + WS_CTL, 0, CTL_ZERO_BYTES, stream) != hipSuccess) { fprintf(stderr, "kernel_launch: memset of the control words failed\n"); return; }
    if (MK_N_LAUNCHES == 1) {
        a.ph_lo = 0; a.ph_hi = 8;
        hipLaunchKernelGGL(fwd_kernel, dim3(grid), dim3(NWAVES * 64), LDS_BYTES, stream, a);
    } else {
        for (int p = 0; p < 8; ++p) { a.ph_lo = p; a.ph_hi = p + 1; hipLaunchKernelGGL(fwd_kernel, dim3(grid), dim3(NWAVES * 64), LDS_BYTES, stream, a); }
    }
}
```

```cpp
#include <hip/hip_runtime.h>
#include <hip/hip_bf16.h>
#include <cstdio>
#include <cstdint>
#include <cmath>

#define LAS __attribute__((address_space(3)))
#define DEV __device__ __forceinline__
typedef unsigned short bf16_t;
typedef short bf16x8 __attribute__((ext_vector_type(8)));
typedef short s16x4 __attribute__((ext_vector_type(4)));
typedef float f32x4 __attribute__((ext_vector_type(4)));
typedef float f32x16 __attribute__((ext_vector_type(16)));
typedef unsigned u32x4 __attribute__((ext_vector_type(4)));
typedef unsigned u32x2 __attribute__((ext_vector_type(2)));

constexpr int NB = 8, SEQ = 4096, DM = 1024, MTOK = NB * SEQ, MEML = 256;
constexpr int IN0 = 3584, IN1 = 5120, MIX = 1536;
constexpr float EPSN = 1e-6f;
constexpr float LOG2E = 1.4426950408889634f;
constexpr float C2_64 = 0.125f * LOG2E;
constexpr float C2_128 = 0.08838834764831845f * LOG2E;
constexpr int Z0_QA = 0, Z0_KA = 512, Z0_VA = 640, Z0_QB = 768, Z0_KB = 1280, Z0_VB = 1408, Z0_QM = 1536, Z0_G = 2048;
constexpr int Z1_QC = 0, Z1_KC = 1024, Z1_VC = 2048, Z1_QM = 3072, Z1_G = 3584;

constexpr size_t MiB = 1u << 20;
constexpr size_t WS_CTL = 0;
constexpr size_t WS_TAB = 1 * MiB;
constexpr int TAB_COS = 0, TAB_SIN = 1024, TAB_BIASB = 2048, TAB_RPB = 2048 + 8 * 384, TAB_END = TAB_RPB + 16 * 15 * 32;
constexpr size_t WS_WIN0 = 2 * MiB, WS_WIN1 = 9 * MiB, WS_WOUT0 = 19 * MiB, WS_WOUT1 = 22 * MiB, WS_WMKV = 25 * MiB, WS_MEMN = 29 * MiB, WS_MKV = 33 * MiB;
constexpr size_t WS_SSQ0 = 41 * MiB, WS_SSQ1 = 43 * MiB, WS_SSQ2 = 45 * MiB;
constexpr size_t WS_XB = 48 * MiB, WS_Z = 112 * MiB, WS_END = 432 * MiB;

constexpr int RING_BYTES = 131072;
constexpr int LDS_TAB_OFF = 98304;
constexpr int LDS_MISC_OFF = 131072 + 320;
constexpr int LDS_BYTES = 147456;
constexpr int CW_BAR = 4096;
constexpr size_t CTL_ZERO_BYTES = 65536;

DEV unsigned f2bf(float f) { unsigned u = __builtin_bit_cast(unsigned, f); return (u + 0x7fffu + ((u >> 16) & 1u)) >> 16; }
typedef float f32x2_t __attribute__((ext_vector_type(2))); typedef __bf16 bf16x2_t __attribute__((ext_vector_type(2)));
DEV unsigned pk2(float lo, float hi) { f32x2_t v = {lo, hi}; bf16x2_t b = __builtin_convertvector(v, bf16x2_t); return __builtin_bit_cast(unsigned, b); }
DEV float bflo(unsigned u) { return __builtin_bit_cast(float, u << 16); }
DEV float bfhi(unsigned u) { return __builtin_bit_cast(float, u & 0xffff0000u); }
DEV float wave_sum(float v) {
#pragma unroll
    for (int o = 1; o < 64; o <<= 1) v += __shfl_xor(v, o);
    return v;
}

namespace pg8 {
constexpr int BM = 256, BK = 64, HALF = 128, HTB = HALF * BK * 2, STAGE_BYTES = 8 * HTB, NXCD = 8, WGM = 8;
__host__ __device__ __forceinline__ int lds_byte(int r, int c) { const int st = (r >> 4) * 2 + (c >> 5), rr = r & 15, cc = c & 31, ob = rr * 64 + cc * 2; return st * 1024 + (ob ^ (((ob >> 9) & 1) << 5)); }
__host__ __device__ __forceinline__ void stage_rc(int b, int& R, int& C) { const int st = b / 1024, sb = b % 1024, swz = sb ^ (((sb >> 9) & 1) << 5); R = (st >> 1) * 16 + swz / 64; C = (st & 1) * 32 + (swz % 64) / 2; }

struct Unit { int pm, pn; };
struct Gemm { const bf16_t* A; const bf16_t* Bt; int M, N, K, lda; };

struct StaticOrder {
    int nM, nN, nwg, G, c;
    __host__ __device__ void init(int M, int N, int G_, int c_) { nM = M / BM; nN = N / BM; nwg = nM * nN; G = G_; c = c_; }
    __host__ __device__ bool next(int i, Unit& u) const {
        const long L = (long)i * G + c; if (L >= nwg) return false;
        int wgid = (int)L; { const int q = nwg / NXCD, r = nwg % NXCD, xcd = wgid % NXCD, off = wgid / NXCD; wgid = (xcd < r ? xcd * (q + 1) : r * (q + 1) + (xcd - r) * q) + off; }
        const int nig = WGM * nN, gid = wgid / nig, fm = gid * WGM, gsz = (nM - fm) < WGM ? (nM - fm) : WGM;
        u.pm = fm + ((wgid % nig) % gsz); u.pn = (wgid % nig) / gsz; return true;
    }
};

template <class Epi, class Sched, bool ALIGN_EPI = false>
__device__ __forceinline__ void gemm_phase(LAS unsigned char* lds, const Gemm g, const Sched& S, const Epi& E) {
    const int tid = threadIdx.x, wid = __builtin_amdgcn_readfirstlane(tid >> 6), lane = tid & 63, wr = wid >> 2, wc = wid & 3, fr = lane & 15, fq = lane >> 4;
    const int K = g.K, nt = K / BK, lda = g.lda;
    unsigned voffA[2], voffB[2];
#pragma unroll
    for (int i = 0; i < 2; ++i) { int R, C; stage_rc(tid * 16 + i * 8192, R, C);
        voffA[i] = (unsigned)(R * lda + C) * 2u; voffB[i] = (unsigned)(R * K + C) * 2u; }
    const size_t kstep = (size_t)(BK * 2);
    const size_t hstepA = (size_t)HALF * lda * 2, hstepB = (size_t)HALF * K * 2;
    const size_t tstepA = 2 * hstepA, tstepB = 2 * hstepB;
    const unsigned ldsw = (unsigned)wid * 1024u;
    const int aoff = lds_byte(wr * 64 + fr, fq * 8), boff = lds_byte(wc * 32 + fr, fq * 8);
#define PG8_SA(b, h) (((b) * 2 + (h)) * HTB)
#define PG8_SB(b, h) ((4 + (b) * 2 + (h)) * HTB)
#define PG8_STAGE(bufoff, gbase, voff) do { _Pragma("unroll") for (int _i = 0; _i < 2; ++_i) \
        __builtin_amdgcn_global_load_lds((const unsigned*)((const char*)(gbase) + (voff)[_i]), (LAS unsigned*)(lds + (bufoff) + ldsw + _i * 8192), 16, 0, 0); } while (0)
#define PG8_LDA(dst, b, h) do { _Pragma("unroll") for (int m = 0; m < 4; ++m) _Pragma("unroll") for (int k = 0; k < 2; ++k) dst[m][k] = *(const LAS bf16x8*)(lds + PG8_SA(b, h) + aoff + m * 2048 + k * 1024); } while (0)
#define PG8_LDB(dst, b, h) do { _Pragma("unroll") for (int n = 0; n < 2; ++n) _Pragma("unroll") for (int k = 0; k < 2; ++k) dst[n][k] = *(const LAS bf16x8*)(lds + PG8_SB(b, h) + boff + n * 2048 + k * 1024); } while (0)
#define PG8_MMA(ai, bj, At, Bt) do { __builtin_amdgcn_s_setprio(1); _Pragma("unroll") for (int m = 0; m < 4; ++m) _Pragma("unroll") for (int n = 0; n < 2; ++n) _Pragma("unroll") for (int k = 0; k < 2; ++k) \
        acc[ai][bj][m][n] = __builtin_amdgcn_mfma_f32_16x16x32_bf16(Bt[n][k], At[m][k], acc[ai][bj][m][n], 0, 0, 0); __builtin_amdgcn_s_setprio(0); } while (0)
#define PG8_WAIT_V(n) asm volatile("s_waitcnt vmcnt(" #n ")" ::: "memory")
#define PG8_WAIT_L(n) asm volatile("s_waitcnt lgkmcnt(" #n ")" ::: "memory")
#define PG8_BAR __builtin_amdgcn_s_barrier()
#define PG8_SCHED __builtin_amdgcn_sched_barrier(0)
    Unit cur, nxt; int ui = 0;
    if (!S.next(0, cur)) return;
    f32x4 acc[2][2][4][2];
#pragma unroll
    for (int a = 0; a < 2; ++a)
#pragma unroll
        for (int b = 0; b < 2; ++b)
#pragma unroll
            for (int m = 0; m < 4; ++m)
#pragma unroll
                for (int n = 0; n < 2; ++n) acc[a][b][m][n] = (f32x4){0.f, 0.f, 0.f, 0.f};
    bf16x8 At[4][2], B0[2][2], B1[2][2];
    const char* cA = (const char*)g.A + (size_t)cur.pm * tstepA; const char* cB = (const char*)g.Bt + (size_t)cur.pn * tstepB;
    PG8_STAGE(PG8_SB(0, 0), cB, voffB); PG8_STAGE(PG8_SB(0, 1), cB + hstepB, voffB); PG8_STAGE(PG8_SA(0, 0), cA, voffA); PG8_STAGE(PG8_SA(0, 1), cA + hstepA, voffA);
    if (wr == 1) PG8_BAR;
    PG8_WAIT_V(2); PG8_BAR;
    PG8_STAGE(PG8_SB(1, 0), cB + kstep, voffB); PG8_STAGE(PG8_SA(1, 0), cA + kstep, voffA); PG8_STAGE(PG8_SB(1, 1), cB + hstepB + kstep, voffB);
    PG8_WAIT_V(6); PG8_BAR;
    for (;;) {
        const bool has_next = S.next(ui + 1, nxt);
        const char* nA = has_next ? (const char*)g.A + (size_t)nxt.pm * tstepA : cA; const char* nB = has_next ? (const char*)g.Bt + (size_t)nxt.pn * tstepB : cB;
        for (int t = 0; t < nt; t += 2) {
            const bool last = (t == nt - 2);
            const char* a1 = cA + (size_t)(t + 1) * kstep;
            const char* a2 = last ? nA : cA + (size_t)(t + 2) * kstep; const char* b2 = last ? nB : cB + (size_t)(t + 2) * kstep;
            const char* a3 = a2 + kstep; const char* b3 = b2 + kstep;
            PG8_LDB(B0, 0, 0); PG8_LDB(B1, 0, 1); PG8_SCHED; PG8_LDA(At, 0, 0); PG8_STAGE(PG8_SA(1, 1), a1 + hstepA, voffA);
            PG8_WAIT_V(8); PG8_WAIT_L(0); PG8_BAR; PG8_MMA(0, 0, At, B0); PG8_MMA(0, 1, At, B1); PG8_BAR; PG8_SCHED;
            PG8_LDA(At, 0, 1); PG8_STAGE(PG8_SB(0, 0), b2, voffB); PG8_STAGE(PG8_SB(0, 1), b2 + hstepB, voffB); PG8_STAGE(PG8_SA(0, 0), a2, voffA);
            PG8_WAIT_V(8); PG8_WAIT_L(0); PG8_BAR; PG8_MMA(1, 0, At, B0); PG8_MMA(1, 1, At, B1); PG8_BAR; PG8_SCHED;
            PG8_LDB(B0, 1, 0); PG8_LDB(B1, 1, 1); PG8_SCHED; PG8_LDA(At, 1, 0); PG8_STAGE(PG8_SA(0, 1), a2 + hstepA, voffA);
            PG8_WAIT_V(8); PG8_WAIT_L(0); PG8_BAR; PG8_MMA(0, 0, At, B0); PG8_MMA(0, 1, At, B1); PG8_BAR; PG8_SCHED;
            PG8_LDA(At, 1, 1); PG8_STAGE(PG8_SB(1, 0), b3, voffB); PG8_STAGE(PG8_SB(1, 1), b3 + hstepB, voffB); PG8_STAGE(PG8_SA(1, 0), a3, voffA);
            PG8_WAIT_V(8); PG8_WAIT_L(0); PG8_BAR; PG8_MMA(1, 0, At, B0); PG8_MMA(1, 1, At, B1); PG8_BAR; PG8_SCHED;
        }
        if constexpr (ALIGN_EPI) { if (wr == 0) PG8_BAR; }
        E(acc, cur, wr, wc, fr, fq);
        if (!has_next) break;
#pragma unroll
        for (int a = 0; a < 2; ++a)
#pragma unroll
            for (int b = 0; b < 2; ++b)
#pragma unroll
                for (int m = 0; m < 4; ++m)
#pragma unroll
                    for (int n = 0; n < 2; ++n) acc[a][b][m][n] = (f32x4){0.f, 0.f, 0.f, 0.f};
        cur = nxt; cA = nA; cB = nB; ++ui;
        if constexpr (ALIGN_EPI) { if (wr == 1) PG8_BAR; }
    }
    PG8_WAIT_V(0);
    if constexpr (!ALIGN_EPI) { if (wr == 0) PG8_BAR; }
    PG8_BAR;
#undef PG8_SA
#undef PG8_SB
#undef PG8_STAGE
#undef PG8_LDA
#undef PG8_LDB
#undef PG8_MMA
#undef PG8_WAIT_V
#undef PG8_WAIT_L
#undef PG8_BAR
#undef PG8_SCHED
}

struct EpiIn {
    bf16_t* Z; int ldz; const float* ssq; int layer; const float* qg; const float* kg; const float* tab;
    __device__ __forceinline__ void operator()(const f32x4 (&acc)[2][2][4][2], const Unit& u, int wr, int wc, int fr, int fq) const {
        const int cb = u.pn * BM + wc * 64;
        int kind = 0; float sc = 1.f; const float* g = qg;
        if (layer == 0) {
            if (cb < Z0_KA) { kind = 1; g = qg; sc = C2_64; }
            else if (cb < Z0_VA) { kind = 1; g = kg; sc = 1.f; }
            else if (cb < Z0_QB) kind = 0;
            else if (cb < Z0_KB) { kind = 2; sc = C2_64; }
            else if (cb < Z0_QM) kind = 0;
            else if (cb < Z0_G) { kind = 2; sc = C2_128; }
            else kind = 3;
        } else {
            if (cb < Z1_KC) { kind = 2; sc = C2_64; }
            else if (cb < Z1_QM) kind = 0;
            else if (cb < Z1_G) { kind = 2; sc = C2_128; }
            else kind = 3;
        }
#pragma unroll
        for (int ai = 0; ai < 2; ++ai)
#pragma unroll
            for (int m = 0; m < 4; ++m) {
                const int row = u.pm * BM + ai * HALF + wr * 64 + m * 16 + fr;
                const f32x4* sp = (const f32x4*)(ssq + (size_t)row * 16);
                const f32x4 s0 = sp[0], s1 = sp[1], s2 = sp[2], s3 = sp[3];
                const float tot = (((s0[0] + s0[1]) + (s0[2] + s0[3])) + ((s1[0] + s1[1]) + (s1[2] + s1[3]))) + (((s2[0] + s2[1]) + (s2[2] + s2[3])) + ((s3[0] + s3[1]) + (s3[2] + s3[3])));
                const float rstd = __builtin_amdgcn_rsqf(tot * (1.0f / DM) + EPSN);
                f32x4 v[2][2];
#pragma unroll
                for (int bj = 0; bj < 2; ++bj)
#pragma unroll
                    for (int n = 0; n < 2; ++n) v[bj][n] = acc[ai][bj][m][n] * rstd;
                if (kind == 1) {
                    float ss = 0.f;
#pragma unroll
                    for (int bj = 0; bj < 2; ++bj)
#pragma unroll
                        for (int n = 0; n < 2; ++n) ss += (v[bj][n][0] * v[bj][n][0] + v[bj][n][1] * v[bj][n][1]) + (v[bj][n][2] * v[bj][n][2] + v[bj][n][3] * v[bj][n][3]);
                    ss += __shfl_xor(ss, 16); ss += __shfl_xor(ss, 32);
                    const float hr = __builtin_amdgcn_rsqf(ss * (1.0f / 64.0f) + EPSN);
#pragma unroll
                    for (int bj = 0; bj < 2; ++bj)
#pragma unroll
                        for (int n = 0; n < 2; ++n) { const f32x4 gv = *(const f32x4*)(g + 32 * bj + 16 * n + 4 * fq); v[bj][n] = v[bj][n] * hr * gv; }
                    const int pos = row & (SEQ - 1);
#pragma unroll
                    for (int bj = 0; bj < 2; ++bj) {
                        const int p = bj == 0 ? (pos >> 6) : (pos & 63);
                        const f32x4 cs = *(const f32x4*)(tab + TAB_COS + p * 16 + 4 * fq), sn = *(const f32x4*)(tab + TAB_SIN + p * 16 + 4 * fq);
                        const f32x4 x1 = v[bj][0], x2 = v[bj][1];
                        v[bj][0] = (x1 * cs - x2 * sn) * sc; v[bj][1] = (x1 * sn + x2 * cs) * sc;
                    }
                } else if (kind == 2) {
#pragma unroll
                    for (int bj = 0; bj < 2; ++bj)
#pragma unroll
                        for (int n = 0; n < 2; ++n) v[bj][n] = v[bj][n] * sc;
                } else if (kind == 3) {
#pragma unroll
                    for (int bj = 0; bj < 2; ++bj)
#pragma unroll
                        for (int n = 0; n < 2; ++n)
#pragma unroll
                            for (int j = 0; j < 4; ++j) { const float x = v[bj][n][j]; v[bj][n][j] = x * __builtin_amdgcn_rcpf(1.0f + __builtin_amdgcn_exp2f(-LOG2E * x)); }
                }
                bf16_t* zp = Z + (size_t)row * ldz + cb + 4 * fq;
#pragma unroll
                for (int bj = 0; bj < 2; ++bj)
#pragma unroll
                    for (int n = 0; n < 2; ++n) { u32x2 w; w.x = pk2(v[bj][n][0], v[bj][n][1]); w.y = pk2(v[bj][n][2], v[bj][n][3]); *(u32x2*)(zp + 32 * bj + 16 * n) = w; }
            }
    }
};
struct EpiPlain {
    bf16_t* O; int ldc;
    __device__ __forceinline__ void operator()(const f32x4 (&acc)[2][2][4][2], const Unit& u, int wr, int wc, int fr, int fq) const {
#pragma unroll
        for (int ai = 0; ai < 2; ++ai)
#pragma unroll
            for (int m = 0; m < 4; ++m) {
                const int row = u.pm * BM + ai * HALF + wr * 64 + m * 16 + fr;
                bf16_t* op = O + (size_t)row * ldc + u.pn * BM + wc * 32 + 4 * fq;
#pragma unroll
                for (int bj = 0; bj < 2; ++bj)
#pragma unroll
                    for (int n = 0; n < 2; ++n) { const f32x4 x = acc[ai][bj][m][n]; u32x2 w; w.x = pk2(x[0], x[1]); w.y = pk2(x[2], x[3]); *(u32x2*)(op + bj * HALF + 16 * n) = w; }
            }
    }
};
struct EpiOut {
    const float* resid; float* xo; bf16_t* xb; float* ssq;
    __device__ __forceinline__ void operator()(const f32x4 (&acc)[2][2][4][2], const Unit& u, int wr, int wc, int fr, int fq) const {
#pragma unroll
        for (int ai = 0; ai < 2; ++ai)
#pragma unroll
            for (int m = 0; m < 4; ++m) {
                const int row = u.pm * BM + ai * HALF + wr * 64 + m * 16 + fr;
                const size_t off = (size_t)row * DM + u.pn * BM + wc * 32 + 4 * fq;
                float ss = 0.f;
#pragma unroll
                for (int bj = 0; bj < 2; ++bj)
#pragma unroll
                    for (int n = 0; n < 2; ++n) {
                        const f32x4 r = *(const f32x4*)(resid + off + bj * HALF + 16 * n);
                        const f32x4 x = acc[ai][bj][m][n] + r;
                        *(f32x4*)(xo + off + bj * HALF + 16 * n) = x;
                        u32x2 w; w.x = pk2(x[0], x[1]); w.y = pk2(x[2], x[3]); *(u32x2*)(xb + off + bj * HALF + 16 * n) = w;
                        ss += (x[0] * x[0] + x[1] * x[1]) + (x[2] * x[2] + x[3] * x[3]);
                    }
                ss += __shfl_xor(ss, 16); ss += __shfl_xor(ss, 32);
                if (fq == 0) ssq[(size_t)row * 16 + u.pn * 4 + wc] = ss;
            }
    }
};
}

namespace sa {
typedef LAS const char* lds_cptr;
#define SBAR() __builtin_amdgcn_sched_barrier(0)
DEV int crow(int r, int hi) { return (r & 3) + 8 * (r >> 2) + 4 * hi; }
DEV void glds16(const void* gsrc, unsigned lds_dst) { unsigned keep;
    asm volatile("s_mov_b32 %0, m0\n\ts_mov_b32 m0, %2\n\ts_nop 0\n\tglobal_load_lds_dwordx4 %1, off\n\ts_mov_b32 m0, %0" : "=&s"(keep) : "v"(gsrc), "s"(lds_dst) : "memory"); }
DEV unsigned cvtpk_s(float lo, float hi) { f32x2_t v = {lo, hi}; bf16x2_t b = __builtin_convertvector(v, bf16x2_t); return __builtin_bit_cast(unsigned, b); }
DEV float rowmax(const f32x16& p0, const f32x16& p1) {
    float a = fmaxf(p0[0], p1[0]);
#pragma unroll
    for (int r = 1; r < 16; ++r) a = fmaxf(a, fmaxf(p0[r], p1[r]));
    auto rr = __builtin_amdgcn_permlane32_swap(__float_as_uint(a), __float_as_uint(a), false, false);
    return fmaxf(__uint_as_float(rr[0]), __uint_as_float(rr[1]));
}
constexpr int OFF_K = 0, OFF_WS = 65536, OFF_OST = 0;
constexpr float NEG_INF = -__builtin_huge_valf();

template <int D, class F>
__device__ __forceinline__ void unit(char* shm, const bf16_t* Qw, int qpitch, const bf16_t* Kt, const bf16_t* Vt, int kvpitch, int nt, const F& f, bf16_t* Ow, int opitch, bool do_store = true) {
    constexpr int SLOT = 64 * D * 2, ND0 = D / 16, NDB = D / 32, NP = D / 64, OFF_V = 2 * SLOT;
    constexpr float THR = 8.0f;
    const int tid = threadIdx.x, lane = tid & 63, r32 = lane & 31, hi = lane >> 5; const int wid = __builtin_amdgcn_readfirstlane(tid >> 6);
    const unsigned lds0 = (unsigned)(uintptr_t)shm;
    const lds_cptr shm3 = (lds_cptr)shm;
    LAS float* wsf = (LAS float*)(shm3 + OFF_WS) + wid * 64;
#define SA_DMA_TILE(j, slotoff) do { const long trow_ = f.tile_row(j); \
    _Pragma("unroll") for (int p_ = 0; p_ < NP; ++p_) { const int c_ = wid + 8 * p_; glds16(Kt + (trow_ + lane) * (long)kvpitch + c_ * 8, (unsigned)__builtin_amdgcn_readfirstlane(lds0 + OFF_K + (slotoff) + c_ * 1024)); } \
    _Pragma("unroll") for (int p_ = 0; p_ < NP; ++p_) { const int bi_ = wid + 8 * p_; glds16(Vt + (trow_ + 16 * (bi_ & 3) + (lane >> 2)) * (long)kvpitch + (bi_ >> 2) * 32 + (lane & 3) * 8, (unsigned)__builtin_amdgcn_readfirstlane(lds0 + OFF_V + (slotoff) + bi_ * 1024)); } } while (0)
    SA_DMA_TILE(0, 0);
    bf16x8 qr[ND0];
#pragma unroll
    for (int d0 = 0; d0 < ND0; ++d0) qr[d0] = *reinterpret_cast<const bf16x8*>(&Qw[(long)r32 * qpitch + d0 * 16 + hi * 8]);
    float mhat = F::has_init ? f.init_m() : 0.f, l_reg = (F::has_init && hi == 0) ? 1.f : 0.f;
    bool started = F::has_init;
    f32x16 o[NDB];
#pragma unroll
    for (int d = 0; d < NDB; ++d) o[d] = f32x16{};
    f32x16 negm;
#pragma unroll
    for (int r = 0; r < 16; ++r) negm[r] = -mhat;
    const int vb0 = (int)(lds0 + OFF_V) + ((lane >> 4) & 1) * 32 + (lane & 3) * 8 + (4 * hi + ((lane & 15) >> 2)) * 64;
    for (int j = 0; j < nt; ++j) {
        const int so = (j & 1) * SLOT;
        if (j + 1 < nt) {
            SA_DMA_TILE(j + 1, ((j + 1) & 1) * SLOT);
            if constexpr (NP == 1) asm volatile("s_waitcnt vmcnt(2) lgkmcnt(0)\n\ts_barrier" ::: "memory");
            else asm volatile("s_waitcnt vmcnt(4) lgkmcnt(0)\n\ts_barrier" ::: "memory");
        } else asm volatile("s_waitcnt vmcnt(0) lgkmcnt(0)\n\ts_barrier" ::: "memory");
        if (f.active(j)) {
            const lds_cptr kp = shm3 + OFF_K + so + hi * 1024 + r32 * 16;
            f32x16 p0, p1;
#pragma unroll
            for (int d0 = 0; d0 < ND0; ++d0) {
                const bf16x8 b0 = *(const LAS bf16x8*)(kp + d0 * 2048), b1 = *(const LAS bf16x8*)(kp + d0 * 2048 + 512);
                if (d0 == 0) { p0 = __builtin_amdgcn_mfma_f32_32x32x16_bf16(b0, qr[0], negm, 0, 0, 0); p1 = __builtin_amdgcn_mfma_f32_32x32x16_bf16(b1, qr[0], negm, 0, 0, 0); }
                else { p0 = __builtin_amdgcn_mfma_f32_32x32x16_bf16(b0, qr[d0], p0, 0, 0, 0); p1 = __builtin_amdgcn_mfma_f32_32x32x16_bf16(b1, qr[d0], p1, 0, 0, 0); }
            }
            f.apply(p0, p1, j);
            const float rm = rowmax(p0, p1);
            if (!started) {
                const float dl = (rm == NEG_INF) ? 0.f : rm;
                mhat = dl;
#pragma unroll
                for (int r = 0; r < 16; ++r) { p0[r] -= dl; p1[r] -= dl; negm[r] = -mhat; }
                started = true;
            } else if (__any(rm > THR)) {
                const float dl = fmaxf(rm, 0.f); mhat += dl;
#pragma unroll
                for (int r = 0; r < 16; ++r) { p0[r] -= dl; p1[r] -= dl; negm[r] = -mhat; }
                const float fs = __builtin_amdgcn_exp2f(-dl); l_reg *= fs;
                if (hi == 0) wsf[r32] = fs;
                asm volatile("s_waitcnt lgkmcnt(0)" ::: "memory");
#pragma unroll
                for (int r = 0; r < 16; ++r) { const float fr_ = wsf[crow(r, hi)];
#pragma unroll
                    for (int d = 0; d < NDB; ++d) o[d][r] *= fr_; }
            }
            float sacc = 0.f;
#pragma unroll
            for (int r = 0; r < 16; ++r) { p0[r] = __builtin_amdgcn_exp2f(p0[r]); p1[r] = __builtin_amdgcn_exp2f(p1[r]); sacc += p0[r] + p1[r]; }
            l_reg += sacc;
            u32x4 pw[4];
#pragma unroll
            for (int q = 0; q < 4; ++q) { pw[0][q] = cvtpk_s(p0[2 * q], p0[2 * q + 1]); pw[1][q] = cvtpk_s(p0[8 + 2 * q], p0[8 + 2 * q + 1]); pw[2][q] = cvtpk_s(p1[2 * q], p1[2 * q + 1]); pw[3][q] = cvtpk_s(p1[8 + 2 * q], p1[8 + 2 * q + 1]); }
            const int vb = vb0 + so;
#pragma unroll
            for (int d0 = 0; d0 < NDB; ++d0) { s16x4 lo[4], hv[4];
#pragma unroll
                for (int ks = 0; ks < 4; ++ks) {
                    asm volatile("ds_read_b64_tr_b16 %0,%1 offset:%c2" : "=&v"(lo[ks]) : "v"(vb), "i"(d0 * 4096 + ks * 1024) : "memory");
                    asm volatile("ds_read_b64_tr_b16 %0,%1 offset:%c2" : "=&v"(hv[ks]) : "v"(vb), "i"(d0 * 4096 + ks * 1024 + 512) : "memory"); }
                asm volatile("s_waitcnt lgkmcnt(0)" ::: "memory"); SBAR();
#pragma unroll
                for (int ks = 0; ks < 4; ++ks) { const bf16x8 vf = (bf16x8){lo[ks][0], lo[ks][1], lo[ks][2], lo[ks][3], hv[ks][0], hv[ks][1], hv[ks][2], hv[ks][3]};
                    o[d0] = __builtin_amdgcn_mfma_f32_32x32x16_bf16(__builtin_bit_cast(bf16x8, pw[ks]), vf, o[d0], 0, 0, 0); }
            }
        }
        asm volatile("s_waitcnt lgkmcnt(0)\n\ts_barrier" ::: "memory");
    }
#undef SA_DMA_TILE
    { auto rr = __builtin_amdgcn_permlane32_swap(__float_as_uint(l_reg), __float_as_uint(l_reg), false, false); l_reg = __uint_as_float(rr[0]) + __uint_as_float(rr[1]); }
    if (hi == 0) wsf[32 + r32] = l_reg;
    asm volatile("s_waitcnt lgkmcnt(0)" ::: "memory");
    LAS bf16_t* stg = (LAS bf16_t*)(shm3 + OFF_OST) + wid * (32 * D);
#pragma unroll
    for (int r = 0; r < 16; ++r) { const int orow = crow(r, hi); const float rli = 1.0f / wsf[32 + orow];
#pragma unroll
        for (int d0 = 0; d0 < NDB; ++d0) stg[orow * D + d0 * 32 + r32] = (bf16_t)f2bf(o[d0][r] * rli); }
    asm volatile("s_waitcnt lgkmcnt(0)" ::: "memory");
    constexpr int CPR = D / 8, NIT = (32 * CPR) / 64;
#pragma unroll
    for (int i = 0; i < NIT; ++i) { const int idx = i * 64 + lane, row = idx / CPR, ch = idx % CPR;
        const u32x4 ov = *(const LAS u32x4*)(stg + row * D + ch * 8);
        bf16_t* gp = Ow + (long)row * opitch + ch * 8;
        const u32x4 gv = *(const u32x4*)gp; u32x4 w;
#pragma unroll
        for (int q = 0; q < 4; ++q) w[q] = pk2(bflo(ov[q]) * bflo(gv[q]), bfhi(ov[q]) * bfhi(gv[q]));
        if (do_store) *(u32x4*)gp = w; }
    asm volatile("s_waitcnt lgkmcnt(0)\n\ts_barrier" ::: "memory");
}
#undef SBAR

struct FDense {
    static constexpr bool has_init = false;
    DEV long tile_row(int j) const { return 64L * j; }
    DEV bool active(int) const { return true; }
    DEV float init_m() const { return 0.f; }
    DEV void apply(f32x16&, f32x16&, int) const {}
};
struct FWindow {
    static constexpr bool has_init = true;
    int t_lo; int qpos0; float sink_l2; LAS const float* tab; int r32, hi;
    DEV long tile_row(int j) const { return t_lo + 64L * j; }
    DEV bool active(int) const { return true; }
    DEV float init_m() const { return sink_l2; }
    DEV void apply(f32x16& p0, f32x16& p1, int j) const {
        LAS const float* tp = tab + (t_lo + 64 * j - qpos0 - r32 + 191 + 4 * hi);
#pragma unroll
        for (int r = 0; r < 16; ++r) { const int o = (r & 3) + 8 * (r >> 2); p0[r] += tp[o]; p1[r] += tp[32 + o]; }
    }
};
struct FNeigh {
    static constexpr bool has_init = false;
    int kr_lo, rq, rs, cq, cs; LAS const float* rpbh; int hi;
    DEV long tile_row(int j) const { return 64L * (kr_lo + j); }
    DEV bool active(int j) const { const int kr = kr_lo + j; return kr >= rs && kr <= rs + 7; }
    DEV float init_m() const { return 0.f; }
    DEV void apply(f32x16& p0, f32x16& p1, int j) const {
        const int dr = kr_lo + j - rq + 7; LAS const float* tp = rpbh + dr * 32;
#pragma unroll
        for (int r = 0; r < 16; ++r) { const int kc = (r & 3) + 8 * (r >> 2) + 4 * hi;
            { const int dc = kc - cq + 15; const bool ok = (unsigned)(kc - cs) < 16u; const float b = tp[dc & 31]; p0[r] = ok ? p0[r] + b : NEG_INF; }
            { const int k2 = kc + 32; const int dc = k2 - cq + 15; const bool ok = (unsigned)(k2 - cs) < 16u; const float b = tp[dc & 31]; p1[r] = ok ? p1[r] + b : NEG_INF; } }
    }
};
}


namespace ga {
using bf16=bf16_t;
constexpr int D=64,DM=IN0;
constexpr int NW=8,QBLK=32,QB=QBLK*NW,KVBLK=64;
__device__ __forceinline__ int crow(int r,int hi){return (r&3)+8*(r>>2)+4*hi;}
#define SBAR() __builtin_amdgcn_sched_barrier(0)
constexpr int NSLOT=3, SLOTB=8192;
constexpr int LDS_K=0, LDS_V=NSLOT*SLOTB, LDS_WS=2*NSLOT*SLOTB, LDS_OST=LDS_WS+NW*64*4, GA_LDS_BYTES=LDS_OST+NW*4096;
constexpr float C2=0.125f*1.4426950408889634f;
__device__ __forceinline__ void glds16(const void*gsrc,unsigned lds_dst){unsigned keep;
  asm volatile("s_mov_b32 %0, m0\n\ts_mov_b32 m0, %2\n\ts_nop 0\n\tglobal_load_lds_dwordx4 %1, off\n\ts_mov_b32 m0, %0":"=&s"(keep):"v"(gsrc),"s"(lds_dst):"memory");}
__device__ __forceinline__ float max3f(float a,float b,float c){float r;asm("v_max3_f32 %0, %1, %2, %3":"=v"(r):"v"(a),"v"(b),"v"(c));return r;}
__device__ __forceinline__ float max2f(float a,float b){float r;asm("v_max_f32_e32 %0, %1, %2":"=v"(r):"v"(a),"v"(b));return r;}
__device__ __forceinline__ float fadd_s(float a,float b){float r;asm("v_add_f32_e32 %0, %1, %2":"=v"(r):"v"(a),"v"(b));return r;}
__device__ __forceinline__ float fsub_s(float a,float b){float r;asm("v_sub_f32_e32 %0, %1, %2":"=v"(r):"v"(a),"v"(b));return r;}
__device__ __forceinline__ unsigned cvtpk_s(float lo,float hi){f32x2_t v={lo,hi};bf16x2_t b=__builtin_convertvector(v,bf16x2_t);return __builtin_bit_cast(unsigned,b);}
#define WAIT_BAR(N) asm volatile("s_waitcnt vmcnt(" #N ") lgkmcnt(0)\n\ts_barrier":::"memory")

__device__ __forceinline__ void qkt(f32x16&p0,f32x16&p1,const char*Kslot,const bf16x8*qr,const f32x16&negm,int r32,int hi){
  const char*kb=Kslot+hi*1024+r32*16;
  #pragma unroll
  for(int d0=0;d0<4;++d0){
    const bf16x8 b0=*reinterpret_cast<const bf16x8*>(kb+d0*2048);
    const bf16x8 b1=*reinterpret_cast<const bf16x8*>(kb+d0*2048+512);
    if(d0==0){p0=__builtin_amdgcn_mfma_f32_32x32x16_bf16(b0,qr[0],negm,0,0,0);p1=__builtin_amdgcn_mfma_f32_32x32x16_bf16(b1,qr[0],negm,0,0,0);}
    else{p0=__builtin_amdgcn_mfma_f32_32x32x16_bf16(b0,qr[d0],p0,0,0,0);p1=__builtin_amdgcn_mfma_f32_32x32x16_bf16(b1,qr[d0],p1,0,0,0);}}
}
typedef __attribute__((address_space(3))) const char* lds_cptr;
typedef short v4i16_t __attribute__((ext_vector_type(4)));
__device__ __forceinline__ void kload8(bf16x8*kf,lds_cptr kp){
  kf[0]=*(const __attribute__((address_space(3))) bf16x8*)(kp);      kf[1]=*(const __attribute__((address_space(3))) bf16x8*)(kp+512);
  kf[2]=*(const __attribute__((address_space(3))) bf16x8*)(kp+2048); kf[3]=*(const __attribute__((address_space(3))) bf16x8*)(kp+2560);
  kf[4]=*(const __attribute__((address_space(3))) bf16x8*)(kp+4096); kf[5]=*(const __attribute__((address_space(3))) bf16x8*)(kp+4608);
  kf[6]=*(const __attribute__((address_space(3))) bf16x8*)(kp+6144); kf[7]=*(const __attribute__((address_space(3))) bf16x8*)(kp+6656);
}
__device__ __forceinline__ void kload2(bf16x8*kf,lds_cptr kp,int j){ kf[2*j]=*(const __attribute__((address_space(3))) bf16x8*)(kp+j*2048); kf[2*j+1]=*(const __attribute__((address_space(3))) bf16x8*)(kp+j*2048+512); }
__device__ __forceinline__ s16x4 vtr(lds_cptr p){ return __builtin_bit_cast(s16x4,__builtin_amdgcn_ds_read_tr16_b64_v4i16((__attribute__((address_space(3))) v4i16_t*)p)); }
__device__ __forceinline__ float rowmax(const f32x16&p0,const f32x16&p1){
  float a=max3f(p0[0],p0[1],p1[0]),b=max3f(p0[2],p0[3],p1[1]);a=max3f(a,p1[2],p1[3]);
  #pragma unroll
  for(int r=4;r<16;r+=4){a=max3f(a,p0[r],p0[r+1]);b=max3f(b,p0[r+2],p0[r+3]);a=max3f(a,p1[r],p1[r+1]);b=max3f(b,p1[r+2],p1[r+3]);}
  const float m=max2f(a,b);
  auto rr=__builtin_amdgcn_permlane32_swap(__float_as_uint(m),__float_as_uint(m),false,false);
  return max2f(__uint_as_float(rr[0]),__uint_as_float(rr[1]));
}
__device__ __forceinline__ void pv(f32x16*o,int vb,bf16x8 pa0,bf16x8 pa1,bf16x8 pa2,bf16x8 pa3){
  #pragma unroll
  for(int d0=0;d0<2;++d0){s16x4 lo[4],hi[4];
    #pragma unroll
    for(int ks=0;ks<4;++ks){
      asm volatile("ds_read_b64_tr_b16 %0,%1 offset:%c2":"=&v"(lo[ks]):"v"(vb),"i"(d0*4096+ks*1024):"memory");
      asm volatile("ds_read_b64_tr_b16 %0,%1 offset:%c2":"=&v"(hi[ks]):"v"(vb),"i"(d0*4096+ks*1024+512):"memory");}
    asm volatile("s_waitcnt lgkmcnt(0)":::"memory");SBAR();
    #define PK(k) (bf16x8){lo[k][0],lo[k][1],lo[k][2],lo[k][3],hi[k][0],hi[k][1],hi[k][2],hi[k][3]}
    o[d0]=__builtin_amdgcn_mfma_f32_32x32x16_bf16(pa0,PK(0),o[d0],0,0,0);
    o[d0]=__builtin_amdgcn_mfma_f32_32x32x16_bf16(pa1,PK(1),o[d0],0,0,0);
    o[d0]=__builtin_amdgcn_mfma_f32_32x32x16_bf16(pa2,PK(2),o[d0],0,0,0);
    o[d0]=__builtin_amdgcn_mfma_f32_32x32x16_bf16(pa3,PK(3),o[d0],0,0,0);
    #undef PK
  }
}

template<int THRL> __device__ __forceinline__ void attn_unit(const bf16*Qw,const bf16*__restrict__ Kh,const bf16*__restrict__ Vh,bf16*Ow,char*shm,bool do_store){
  const int tid=threadIdx.x,lane=tid&63,r32=lane&31,hi=lane>>5; const int wid=__builtin_amdgcn_readfirstlane(tid>>6);
  const unsigned lds0=(unsigned)(uintptr_t)shm;
  LAS float*wsf=(LAS float*)((LAS char*)shm+LDS_WS)+wid*64;
  const bf16*ksrc=Kh+(long)lane*DM+wid*8;
  const bf16*vsrc=Vh+(long)(16*(wid&3)+(lane>>2))*DM+(wid>>2)*32+(lane&3)*8;
  const unsigned kdst=lds0+LDS_K+wid*1024, vdst=lds0+LDS_V+wid*1024;
  #define DMA_K(t,slot) glds16(ksrc+(long)(t)*KVBLK*DM,(unsigned)__builtin_amdgcn_readfirstlane(kdst+(slot)))
  #define DMA_V(t,slot) glds16(vsrc+(long)(t)*KVBLK*DM,(unsigned)__builtin_amdgcn_readfirstlane(vdst+(slot)))
  const int vb0=(int)(lds0+LDS_V)+((lane>>4)&1)*32+(lane&3)*8+(4*hi+((lane&15)>>2))*64;
  const char*Kbase=shm+LDS_K; bf16x8 kf[8];
  const lds_cptr shm3=(lds_cptr)shm; const lds_cptr kp0=shm3+LDS_K+hi*1024+r32*16; const lds_cptr vp0=shm3+LDS_V+((lane>>4)&1)*32+(lane&3)*8+(4*hi+((lane&15)>>2))*64;
  constexpr int NT=SEQ/KVBLK;
  DMA_K(0,0);DMA_V(0,0);DMA_K(1,SLOTB);
  bf16x8 qr[4];
  #pragma unroll
  for(int d0=0;d0<4;++d0)qr[d0]=*reinterpret_cast<const bf16x8*>(&Qw[(long)r32*DM+d0*16+hi*8]);
  float mhat=0.f,l_reg=0.f;f32x16 o[2];o[0]=f32x16{};o[1]=f32x16{};f32x16 negm=f32x16{};asm volatile("":"+v"(negm));
  #define CMASK(P0,P1,t) do{}while(0)
  bool resc=false;
  #define START(P0,P1) do{ const float rm=rowmax(P0,P1); resc=false; \
    { const float dl=rm; mhat=fadd_s(mhat,dl); \
      _Pragma("unroll") for(int r=0;r<16;++r){P0[r]=fsub_s(P0[r],dl);P1[r]=fsub_s(P1[r],dl);} \
      _Pragma("unroll") for(int r=0;r<16;++r)negm[r]=-mhat; asm volatile("":"+v"(negm)); } \
    _Pragma("unroll") for(int r=0;r<16;++r)P0[r]=__builtin_amdgcn_exp2f(P0[r]); }while(0)
  #define RESC() do{ if(resc){ asm volatile("s_waitcnt lgkmcnt(0)":::"memory"); \
      _Pragma("unroll") for(int d_=0;d_<2;++d_) _Pragma("unroll") for(int r=0;r<16;++r)o[d_][r]*=wsf[crow(r,hi)]; } }while(0)
  f32x16 pA0,pA1,pB0,pB1;
  int sl_prev=0,sl_cur=0,sl_next=SLOTB;
  #define ROT() do{sl_prev=sl_cur;sl_cur=sl_next;sl_next=(sl_next==(NSLOT-1)*SLOTB)?0:sl_next+SLOTB;}while(0)
  DMA_K(2,2*SLOTB);
  WAIT_BAR(3);
  qkt(pA0,pA1,Kbase,qr,negm,r32,hi);asm volatile("s_nop 15\n\ts_nop 7":"+v"(pA0),"+v"(pA1));CMASK(pA0,pA1,0);
  START(pA0,pA1);
  _Pragma("unroll") for(int r=0;r<16;++r)pA1[r]=__builtin_amdgcn_exp2f(pA1[r]);
  WAIT_BAR(0);
  DMA_K(3,0);DMA_V(1,SLOTB);
  ROT();
  kload8(kf,kp0+sl_cur);
  WAIT_BAR(2);
  s16x4 vlo[8],vhi[8]; u32x4 pw0,pw1,pw2,pw3;
  #define PKW(P,B) cvtpk_s(P[B],P[B+1])
  #define PAF(k) __builtin_bit_cast(bf16x8,pw##k)
  #define VFR(i) (bf16x8){vlo[i][0],vlo[i][1],vlo[i][2],vlo[i][3],vhi[i][0],vhi[i][1],vhi[i][2],vhi[i][3]}
  #define PIN(x) asm volatile("":"+v"(x))
  #define MX3(a,b,c) __builtin_fmaxf(__builtin_fmaxf((a),(b)),(c))
  #define GAPA(MF,A0,A1,A2,A3,W0,W1,PW) do{ MF; sacc+=A0; sacc+=A1; sacc+=A2; sacc+=A3; PIN(sacc); W0; W1; PIN(PW); SBAR(); }while(0)
  #define EX(v) __builtin_amdgcn_exp2f(v)
  #define GAPB(MF,X,B) do{ MF; X[B]=EX(X[B]); X[B+1]=EX(X[B+1]); X[B+2]=EX(X[B+2]); X[B+3]=EX(X[B+3]); PIN(X); SBAR(); }while(0)
  #define VRD(i) do{ vlo[i]=vtr(vp_+(((i)>>2)*4096+((i)&3)*1024)); vhi[i]=vtr(vp_+(((i)>>2)*4096+((i)&3)*1024+512)); }while(0)
  #define KRD(G,j) do{ if(G){ kload2(kf,kp0+sl_next,j); SBAR(); } }while(0)
  #define STEP(C0,C1,P0,P1,t,GK,GV,GL) do{ SBAR(); \
    const lds_cptr vp_=vp0+sl_prev; \
    VRD(0); SBAR(); float sacc=(P0[0]+P0[1]); \
    GAPA(C0=__builtin_amdgcn_mfma_f32_32x32x16_bf16(kf[0],qr[0],negm,0,0,0), P0[2],P0[3],P0[4],P0[5],     pw0[0]=PKW(P0,0), pw0[1]=PKW(P0,2), pw0); \
    VRD(4); SBAR(); GAPA(C1=__builtin_amdgcn_mfma_f32_32x32x16_bf16(kf[1],qr[0],negm,0,0,0), P0[6],P0[7],P0[8],P0[9],     pw0[2]=PKW(P0,4), pw0[3]=PKW(P0,6), pw0); \
    VRD(1); SBAR(); GAPA(C0=__builtin_amdgcn_mfma_f32_32x32x16_bf16(kf[2],qr[1],C0,0,0,0),   P0[10],P0[11],P0[12],P0[13], pw1[0]=PKW(P0,8), pw1[1]=PKW(P0,10), pw1); \
    VRD(5); SBAR(); GAPA(C1=__builtin_amdgcn_mfma_f32_32x32x16_bf16(kf[3],qr[1],C1,0,0,0),   P0[14],P0[15],P1[0],P1[1],   pw1[2]=PKW(P0,12),pw1[3]=PKW(P0,14), pw1); \
    VRD(2); SBAR(); GAPA(C0=__builtin_amdgcn_mfma_f32_32x32x16_bf16(kf[4],qr[2],C0,0,0,0),   P1[2],P1[3],P1[4],P1[5],     pw2[0]=PKW(P1,0), pw2[1]=PKW(P1,2), pw2); \
    VRD(6); SBAR(); GAPA(C1=__builtin_amdgcn_mfma_f32_32x32x16_bf16(kf[5],qr[2],C1,0,0,0),   P1[6],P1[7],P1[8],P1[9],     pw2[2]=PKW(P1,4), pw2[3]=PKW(P1,6), pw2); \
    VRD(3); SBAR(); GAPA(C0=__builtin_amdgcn_mfma_f32_32x32x16_bf16(kf[6],qr[3],C0,0,0,0),   P1[10],P1[11],P1[12],P1[13], pw3[0]=PKW(P1,8), pw3[1]=PKW(P1,10), pw3); \
    VRD(7); SBAR(); GAPA(C1=__builtin_amdgcn_mfma_f32_32x32x16_bf16(kf[7],qr[3],C1,0,0,0),   P1[14],P1[15],0.f,0.f,       pw3[2]=PKW(P1,12),pw3[3]=PKW(P1,14), pw3); \
    l_reg+=sacc; \
    if(GK){DMA_K((t)+3,sl_cur);} if(GV){DMA_V((t)+1,sl_next);} \
    CMASK(C0,C1,t); \
    { float a=MX3(C0[0],C0[1],C1[0]),b=MX3(C0[2],C0[3],C1[1]); a=MX3(a,C1[2],C1[3]); \
      _Pragma("unroll") for(int r=4;r<16;r+=4){a=MX3(a,C0[r],C0[r+1]);b=MX3(b,C0[r+2],C0[r+3]);a=MX3(a,C1[r],C1[r+1]);b=MX3(b,C1[r+2],C1[r+3]);} \
      float rm=__builtin_fmaxf(a,b); { auto rr=__builtin_amdgcn_permlane32_swap(__float_as_uint(rm),__float_as_uint(rm),false,false); rm=__builtin_fmaxf(__uint_as_float(rr[0]),__uint_as_float(rr[1])); } \
      resc=false; \
      if(__builtin_expect(__any(rm>(float)THRL),0)){ const float dl=__builtin_fmaxf(rm,0.f); mhat+=dl; \
        _Pragma("unroll") for(int r=0;r<16;++r){C0[r]-=dl;C1[r]-=dl;} \
        _Pragma("unroll") for(int r=0;r<16;++r)negm[r]=-mhat; asm volatile("":"+v"(negm)); \
        const float f=__builtin_amdgcn_exp2f(-dl); l_reg*=f; if(hi==0)wsf[r32]=f; resc=true; } } \
    SBAR(); \
    GAPB(o[0]=__builtin_amdgcn_mfma_f32_32x32x16_bf16(PAF(0),VFR(0),o[0],0,0,0), C0,0); \
    GAPB(o[1]=__builtin_amdgcn_mfma_f32_32x32x16_bf16(PAF(0),VFR(4),o[1],0,0,0), C0,4); \
    KRD(GL,0); GAPB(o[0]=__builtin_amdgcn_mfma_f32_32x32x16_bf16(PAF(1),VFR(1),o[0],0,0,0), C0,8); \
    KRD(GL,1); GAPB(o[1]=__builtin_amdgcn_mfma_f32_32x32x16_bf16(PAF(1),VFR(5),o[1],0,0,0), C0,12); \
    KRD(GL,2); GAPB(o[0]=__builtin_amdgcn_mfma_f32_32x32x16_bf16(PAF(2),VFR(2),o[0],0,0,0), C1,0); \
    KRD(GL,3); GAPB(o[1]=__builtin_amdgcn_mfma_f32_32x32x16_bf16(PAF(2),VFR(6),o[1],0,0,0), C1,4); \
    GAPB(o[0]=__builtin_amdgcn_mfma_f32_32x32x16_bf16(PAF(3),VFR(3),o[0],0,0,0), C1,8); \
    GAPB(o[1]=__builtin_amdgcn_mfma_f32_32x32x16_bf16(PAF(3),VFR(7),o[1],0,0,0), C1,12); \
    }while(0)
  int t=1;
  #undef CMASK
  #define CMASK(P0,P1,t) do{}while(0)
  for(;t+5<NT;t+=2){
    STEP(pB0,pB1,pA0,pA1,t,true,true,true);     WAIT_BAR(2); RESC(); ROT();
    STEP(pA0,pA1,pB0,pB1,t+1,true,true,true);   WAIT_BAR(2); RESC(); ROT();
  }
  #undef CMASK
  #define CMASK(P0,P1,t) do{}while(0)
  #define ENDW(tt) do{ if((tt)+3<NT){WAIT_BAR(2);} else if((tt)+2<NT){WAIT_BAR(1);} else {WAIT_BAR(0);} }while(0)
  for(;t+1<NT;t+=2){
    STEP(pB0,pB1,pA0,pA1,t,(t+3<NT),(t+1<NT),(t+1<NT));       ENDW(t);   RESC(); ROT();
    STEP(pA0,pA1,pB0,pB1,t+1,(t+4<NT),(t+2<NT),(t+2<NT));     ENDW(t+1); RESC(); ROT();
  }
  STEP(pB0,pB1,pA0,pA1,NT-1,false,false,false); RESC();
  { float sacc=pB0[0]+pB0[1]; _Pragma("unroll") for(int r=2;r<16;++r)sacc+=pB0[r]; _Pragma("unroll") for(int r=0;r<16;++r)sacc+=pB1[r]; l_reg+=sacc;
    pw0=(u32x4){PKW(pB0,0),PKW(pB0,2),PKW(pB0,4),PKW(pB0,6)};pw1=(u32x4){PKW(pB0,8),PKW(pB0,10),PKW(pB0,12),PKW(pB0,14)};pw2=(u32x4){PKW(pB1,0),PKW(pB1,2),PKW(pB1,4),PKW(pB1,6)};pw3=(u32x4){PKW(pB1,8),PKW(pB1,10),PKW(pB1,12),PKW(pB1,14)};
    SBAR(); pv(o,vb0+sl_cur,PAF(0),PAF(1),PAF(2),PAF(3)); }
  #undef PKW
  #undef PAF
  #undef VFR
  #undef PIN
  #undef MX3
  #undef GAPA
  #undef GAPB
  #undef EX
  #undef VRD
  #undef KRD
  #undef STEP
  #undef ENDW
  {auto rr=__builtin_amdgcn_permlane32_swap(__float_as_uint(l_reg),__float_as_uint(l_reg),false,false);l_reg=__uint_as_float(rr[0])+__uint_as_float(rr[1]);}
  if(hi==0)wsf[32+r32]=l_reg;asm volatile("s_waitcnt lgkmcnt(0)":::"memory");
  float rli[16];
  #pragma unroll
  for(int r=0;r<16;++r)rli[r]=__builtin_amdgcn_rcpf(wsf[32+crow(r,hi)]);
  { LAS bf16*stg=(LAS bf16*)((LAS char*)shm+LDS_OST)+wid*2048;
    #pragma unroll
    for(int r=0;r<16;++r){const int orow=crow(r,hi);
      #pragma unroll
      for(int d0=0;d0<2;++d0)stg[orow*64+d0*32+r32]=(bf16)f2bf(o[d0][r]*rli[r]);}
    asm volatile("s_waitcnt lgkmcnt(0)":::"memory");
    #pragma unroll
    for(int i=0;i<4;++i){const int row=i*8+(lane>>3),ch=lane&7; const u32x4 v=*(const LAS u32x4*)(stg+row*64+ch*8);
      bf16*gp=Ow+(long)row*DM+ch*8; const u32x4 gv=*(const u32x4*)gp; u32x4 w;
      #pragma unroll
      for(int q_=0;q_<4;++q_)w[q_]=pk2(bflo(v[q_])*bflo(gv[q_]),bfhi(v[q_])*bfhi(gv[q_]));
      if(do_store)*(u32x4*)gp=w;} }
  asm volatile("s_waitcnt lgkmcnt(0)\n\ts_barrier":::"memory");
  #undef DMA_K
  #undef DMA_V
  #undef CMASK
  #undef START
  #undef RESC
  #undef ROT
}
constexpr int ATTN_LDS_BYTES=GA_LDS_BYTES;
#undef SBAR
#undef WAIT_BAR
}

namespace na {
typedef LAS const char* lds_cptr;
constexpr int SLOT = 16384, NS = 6, PD = 5, OFF_TAB = NS * SLOT;
constexpr float NEG_INF = -__builtin_huge_valf();
DEV int clip(int v, int a, int c) { return v < a ? a : (v > c ? c : v); }
__device__ __forceinline__ void unit(char* shm, const bf16_t* Zb, int h, int r0, bool do_store) {
    constexpr float THR = 8.0f;
    const int tid = threadIdx.x, lane = tid & 63, q = lane & 15, g = lane >> 4; const int wid = __builtin_amdgcn_readfirstlane(tid >> 6);
    const unsigned lds0 = (unsigned)(uintptr_t)shm; const lds_cptr shm3 = (lds_cptr)shm;
    LAS const float* ltab = (LAS const float*)(shm3 + OFF_TAB);
    const int rq = r0 + (wid >> 2), g4 = wid & 3, cq = 16 * g4 + q;
    const int kb = g4 == 0 ? 0 : (g4 == 1 ? 8 : (g4 == 2 ? 24 : 32));
    const int kr_lo = clip(r0 - 4, 0, 56), kr_hi = clip(r0 - 3, 0, 56) + 7, nt = kr_hi - kr_lo + 1;
    const int rs = clip(rq - 4, 0, 56), cs = clip(cq - 8, 0, 48);
    const bf16_t* Kb = Zb + Z1_KC + h * 64; const bf16_t* Vb = Zb + Z1_VC + h * 64;
    const bf16_t* Qrow = Zb + (long)(rq * 64 + cq) * IN1 + Z1_QC + h * 64;
    bf16x8 qf[2];
#pragma unroll
    for (int s_ = 0; s_ < 2; ++s_) qf[s_] = *reinterpret_cast<const bf16x8*>(Qrow + 32 * s_ + 8 * g);
    const long dsrc = (long)(8 * wid + (lane >> 3)) * IN1 + (((lane & 7) ^ (lane >> 3)) << 3);
#define NA_DMA(j, slotoff) do { const long tok_ = (long)(kr_lo + (j)) * 64 * IN1 + dsrc; \
    sa::glds16(Kb + tok_, (unsigned)__builtin_amdgcn_readfirstlane(lds0 + (slotoff) + wid * 1024)); \
    sa::glds16(Vb + tok_, (unsigned)__builtin_amdgcn_readfirstlane(lds0 + (slotoff) + 8192 + wid * 1024)); } while (0)
    NA_DMA(0, 0); NA_DMA(1, SLOT); NA_DMA(2, 2 * SLOT); NA_DMA(3, 3 * SLOT); NA_DMA(4, 4 * SLOT);
    float mhat = 0.f, l_reg = 0.f; bool started = false;
    f32x4 OT[4];
#pragma unroll
    for (int d = 0; d < 4; ++d) OT[d] = (f32x4){0.f, 0.f, 0.f, 0.f};
    f32x4 negm = (f32x4){0.f, 0.f, 0.f, 0.f};
    const int mb = kb + 4 * g - cs;
    const int tbase = kb - cq + 31 + 4 * g;
    const int koff0 = (kb + q) * 128 + ((g ^ (q & 7)) << 4), koff1 = (kb + q) * 128 + (((4 + g) ^ (q & 7)) << 4);
    const int vrow = kb + 4 * g + (q >> 2), vx = vrow & 7, vp = q & 3;
    unsigned voff[4];
#pragma unroll
    for (int db = 0; db < 4; ++db) voff[db] = (unsigned)(8192 + vrow * 128 + (((2 * db + (vp >> 1)) ^ vx) << 4) + (vp & 1) * 8);
    int so = 0, sop = PD * SLOT;
    for (int j = 0; j < nt; ++j) {
        const int nafter = (nt - 1 - j) < (PD - 1) ? (nt - 1 - j) : (PD - 1);
        if (nafter == 4) asm volatile("s_waitcnt vmcnt(8) lgkmcnt(0)\n\ts_barrier" ::: "memory");
        else if (nafter == 3) asm volatile("s_waitcnt vmcnt(6) lgkmcnt(0)\n\ts_barrier" ::: "memory");
        else if (nafter == 2) asm volatile("s_waitcnt vmcnt(4) lgkmcnt(0)\n\ts_barrier" ::: "memory");
        else if (nafter == 1) asm volatile("s_waitcnt vmcnt(2) lgkmcnt(0)\n\ts_barrier" ::: "memory");
        else asm volatile("s_waitcnt vmcnt(0) lgkmcnt(0)\n\ts_barrier" ::: "memory");
        if (j + PD < nt) NA_DMA(j + PD, sop);
        const int kr = kr_lo + j;
        if (kr >= rs && kr <= rs + 7) {
            const lds_cptr kp = shm3 + so;
            const bf16x8 a00 = *(const LAS bf16x8*)(kp + koff0), a01 = *(const LAS bf16x8*)(kp + koff0 + 2048), a10 = *(const LAS bf16x8*)(kp + koff1), a11 = *(const LAS bf16x8*)(kp + koff1 + 2048);
            f32x4 S0 = __builtin_amdgcn_mfma_f32_16x16x32_bf16(a00, qf[0], negm, 0, 0, 0); S0 = __builtin_amdgcn_mfma_f32_16x16x32_bf16(a10, qf[1], S0, 0, 0, 0);
            f32x4 S1 = __builtin_amdgcn_mfma_f32_16x16x32_bf16(a01, qf[0], negm, 0, 0, 0); S1 = __builtin_amdgcn_mfma_f32_16x16x32_bf16(a11, qf[1], S1, 0, 0, 0);
            LAS const float* tp = ltab + (kr - rq + 7) * 64 + tbase;
#pragma unroll
            for (int r = 0; r < 4; ++r) {
                S0[r] = ((unsigned)(mb + r) < 16u) ? S0[r] + tp[r] : NEG_INF;
                S1[r] = ((unsigned)(mb + 16 + r) < 16u) ? S1[r] + tp[16 + r] : NEG_INF; }
            float rm = fmaxf(fmaxf(fmaxf(S0[0], S0[1]), fmaxf(S0[2], S0[3])), fmaxf(fmaxf(S1[0], S1[1]), fmaxf(S1[2], S1[3])));
            rm = fmaxf(rm, __shfl_xor(rm, 16)); rm = fmaxf(rm, __shfl_xor(rm, 32));
            if (!started) {
                const float dl = (rm == NEG_INF) ? 0.f : rm; mhat = dl;
#pragma unroll
                for (int r = 0; r < 4; ++r) { S0[r] -= dl; S1[r] -= dl; negm[r] = -mhat; }
                started = true;
            } else if (__any(rm > THR)) {
                const float dl = fmaxf(rm, 0.f); mhat += dl;
                const float fs = __builtin_amdgcn_exp2f(-dl); l_reg *= fs;
#pragma unroll
                for (int r = 0; r < 4; ++r) { S0[r] -= dl; S1[r] -= dl; negm[r] = -mhat; }
#pragma unroll
                for (int d = 0; d < 4; ++d) OT[d] = OT[d] * fs;
            }
#pragma unroll
            for (int r = 0; r < 4; ++r) { S0[r] = __builtin_amdgcn_exp2f(S0[r]); S1[r] = __builtin_amdgcn_exp2f(S1[r]); }
            l_reg += ((S0[0] + S0[1]) + (S0[2] + S0[3])) + ((S1[0] + S1[1]) + (S1[2] + S1[3]));
            u32x4 pw; pw[0] = pk2(S0[0], S0[1]); pw[1] = pk2(S0[2], S0[3]); pw[2] = pk2(S1[0], S1[1]); pw[3] = pk2(S1[2], S1[3]);
            const bf16x8 pf = __builtin_bit_cast(bf16x8, pw);
            const unsigned vb = lds0 + (unsigned)so;
            s16x4 lo[4], hv[4];
#pragma unroll
            for (int db = 0; db < 4; ++db) {
                asm volatile("ds_read_b64_tr_b16 %0, %1" : "=&v"(lo[db]) : "v"(vb + voff[db]) : "memory");
                asm volatile("ds_read_b64_tr_b16 %0, %1 offset:2048" : "=&v"(hv[db]) : "v"(vb + voff[db]) : "memory"); }
            asm volatile("s_waitcnt lgkmcnt(0)" ::: "memory"); __builtin_amdgcn_sched_barrier(0);
#pragma unroll
            for (int db = 0; db < 4; ++db) {
                const bf16x8 vf = (bf16x8){lo[db][0], lo[db][1], lo[db][2], lo[db][3], hv[db][0], hv[db][1], hv[db][2], hv[db][3]};
                OT[db] = __builtin_amdgcn_mfma_f32_16x16x32_bf16(vf, pf, OT[db], 0, 0, 0);
            }
        }
        so = so == (NS - 1) * SLOT ? 0 : so + SLOT; sop = sop == (NS - 1) * SLOT ? 0 : sop + SLOT;
    }
#undef NA_DMA
    l_reg += __shfl_xor(l_reg, 16); l_reg += __shfl_xor(l_reg, 32);
    const float rl = 1.0f / l_reg;
    bf16_t* gp = (bf16_t*)Zb + (long)(rq * 64 + cq) * IN1 + Z1_G + h * 64 + 4 * g;
#pragma unroll
    for (int db = 0; db < 4; ++db) { const u32x2 gv = *(const u32x2*)(gp + 16 * db); const f32x4 o = OT[db] * rl; u32x2 w;
        w.x = pk2(o[0] * bflo(gv.x), o[1] * bfhi(gv.x)); w.y = pk2(o[2] * bflo(gv.y), o[3] * bfhi(gv.y));
        if (do_store) *(u32x2*)(gp + 16 * db) = w; }
    asm volatile("s_waitcnt lgkmcnt(0)\n\ts_barrier" ::: "memory");
}
}


#define GAS __attribute__((address_space(1)))
#define XB_TMO      128
#define XB_XCNT(j)  (256  + 64 * (j))
#define XB_XSUB(j)  (1280 + 64 * (j))
#define XB_XGEN(j)  (2304 + 64 * (j))
#define XB_TOP      3328
#define XB_TOPGEN   3392
#define XCD_BAR_WORDS 3456
#define XB_SPIN_CAP (1u << 18)
__device__ __forceinline__ unsigned xb_ld(unsigned* p)              { return __hip_atomic_load(p, __ATOMIC_RELAXED, __HIP_MEMORY_SCOPE_AGENT); }
__device__ __forceinline__ unsigned xb_add(unsigned* p, unsigned v) { return __hip_atomic_fetch_add(p, v, __ATOMIC_RELAXED, __HIP_MEMORY_SCOPE_AGENT); }
__device__ __forceinline__ unsigned xb_xcc_id() { return (unsigned)__builtin_amdgcn_s_getreg((3 << 11) | 20) & 0xFu; }
#define XB_SPIN(cond, bar) do { unsigned _sp = 0; while (cond) { __builtin_amdgcn_s_sleep(1); \
    if ((++_sp & 255u) == 0u) { if (xb_ld(&(bar)[XB_TMO])) break; if (_sp > XB_SPIN_CAP) { atomicAdd(&(bar)[XB_TMO], 1u); break; } } } } while (0)
struct XcdBarrier { unsigned* bar; unsigned x; volatile LAS unsigned* st; };
__device__ __forceinline__ XcdBarrier xcd_barrier_post(unsigned* bar, volatile LAS unsigned* st) {
    XcdBarrier b; b.bar = bar; b.x = xb_xcc_id(); b.st = st;
    if (threadIdx.x == 0) (void)xb_add(&bar[XB_XCNT(b.x)], 1u);
    return b;
}
__device__ __forceinline__ void xcd_barrier_complete(unsigned* bar, unsigned x, unsigned& nloc, unsigned& nx) {
    const unsigned G = gridDim.x * gridDim.y * gridDim.z;
    unsigned sum, cnt, mine, sp = 0u;
    for (;;) {
        sum = 0u; cnt = 0u; mine = 0u;
#pragma unroll
        for (unsigned j = 0; j < 16; ++j) { const unsigned c = xb_ld(&bar[XB_XCNT(j)]); sum += c; cnt += (c > 0u) ? 1u : 0u; mine = (j == x) ? c : mine; }
        if (sum == G) break;
        __builtin_amdgcn_s_sleep(1);
        if ((++sp & 255u) == 0u) { if (xb_ld(&bar[XB_TMO])) break; if (sp > XB_SPIN_CAP) { atomicAdd(&bar[XB_TMO], 1u); break; } }
    }
    nloc = mine > 0u ? mine : 1u; nx = cnt > 0u ? cnt : 1u;
}
__device__ __forceinline__ void xcd_barrier(const XcdBarrier& b) {
    asm volatile("s_waitcnt vmcnt(0)" ::: "memory");
    __syncthreads();
    if (threadIdx.x == 0) {
        unsigned* bar = b.bar;
        __builtin_amdgcn_s_waitcnt(0);
        unsigned nloc = b.st[0], nx = b.st[1];
        if (nloc == 0u) { xcd_barrier_complete(bar, b.x, nloc, nx); b.st[0] = nloc; b.st[1] = nx; }
        const unsigned old = xb_add(&bar[XB_XSUB(b.x)], 1u);
        const unsigned gen = old / nloc;
        if (old + 1u == (gen + 1u) * nloc) {
            __builtin_amdgcn_fence(__ATOMIC_RELEASE, "agent");
            asm volatile("s_waitcnt vmcnt(0)" ::: "memory");
            const unsigned og = xb_add(&bar[XB_TOP], 1u);
            const unsigned tg = og / nx;
            if (og + 1u == (tg + 1u) * nx) xb_add(&bar[XB_TOPGEN], 1u);
            else XB_SPIN(xb_ld(&bar[XB_TOPGEN]) == tg, bar);
            __builtin_amdgcn_fence(__ATOMIC_ACQUIRE, "agent");
            xb_add(&bar[XB_XGEN(b.x)], 1u);
            asm volatile("s_waitcnt vmcnt(0)" ::: "memory");
        } else {
            XB_SPIN(xb_ld(&bar[XB_XGEN(b.x)]) == gen, bar);
            __builtin_amdgcn_fence(__ATOMIC_ACQUIRE, "agent");
            asm volatile("s_waitcnt vmcnt(0)" ::: "memory");
        }
    }
    __syncthreads();
}
constexpr int NWAVES = 8;
#ifndef PROBE_REP
#define PROBE_REP 0
#endif
struct Args { const float* in[15]; float* out; unsigned char* ws; int ph_lo, ph_hi; };

DEV void transpose_item(const float* W, int N, int K, bf16_t* WT, int k0, int n0, int dst_row0, const float* gain, LAS float* scr, int lane) {
#pragma unroll 8
    for (int i = 0; i < 32; ++i) { const int kk = 2 * i + (lane >> 5); scr[kk * 33 + (lane & 31)] = W[(size_t)(k0 + kk) * N + n0 + (lane & 31)]; }
    asm volatile("s_waitcnt lgkmcnt(0)" ::: "memory");
    const int c = lane & 7;
    float gk[8];
#pragma unroll
    for (int i = 0; i < 8; ++i) gk[i] = gain ? gain[k0 + 8 * c + i] : 1.0f;
#pragma unroll
    for (int j = 0; j < 4; ++j) { const int n = (lane >> 3) + 8 * j; const LAS float* s = scr + (8 * c) * 33 + n;
        u32x4 o; o.x = pk2(s[0 * 33] * gk[0], s[1 * 33] * gk[1]); o.y = pk2(s[2 * 33] * gk[2], s[3 * 33] * gk[3]); o.z = pk2(s[4 * 33] * gk[4], s[5 * 33] * gk[5]); o.w = pk2(s[6 * 33] * gk[6], s[7 * 33] * gk[7]);
        *(u32x4*)(WT + (size_t)(dst_row0 + n) * K + k0 + 8 * c) = o; }
    asm volatile("s_waitcnt lgkmcnt(0)" ::: "memory");
}
DEV int perm_row0(int n0) { const int t = n0 >> 8, gl = (n0 & 255) >> 5, wc = gl >> 1, bj = gl & 1; return (t << 8) + 32 * (4 * bj + wc); }

DEV int t5_bucket(int rel) {
    const int n = rel < 0 ? -rel : rel; int b = rel > 0 ? 16 : 0;
    if (n < 8) return b + n;
    int large = 2 + (31 - __clz(n * n)); if (large > 15) large = 15;
    return b + large;
}

__global__ void __launch_bounds__(NWAVES * 64, 2) fwd_kernel(Args args) {
    extern __shared__ __attribute__((aligned(16))) unsigned char lds[];
    const int tid = threadIdx.x, lane = tid & 63, wave = __builtin_amdgcn_readfirstlane(tid >> 6);
    const int G = gridDim.x; const int bx = blockIdx.x; const int vcu = (G % 8 == 0) ? (bx % 8) * (G / 8) + bx / 8 : bx;
    unsigned char* ws = args.ws;
    const float* x = args.in[0]; const float* mem = args.in[1]; const float* norm_gain = args.in[2]; const float* mem_gain = args.in[3];
    const float* w_in0 = args.in[4]; const float* w_out0 = args.in[5]; const float* q_norm = args.in[6]; const float* k_norm = args.in[7];
    const float* sink_b = args.in[8]; const float* rel_bias = args.in[9]; const float* w_in1 = args.in[10]; const float* w_out1 = args.in[11];
    const float* rpb_c = args.in[12]; const float* w_mkv = args.in[13]; const float* fin_gain = args.in[14];
    float* out = args.out;
    float* tab = (float*)(ws + WS_TAB);
    bf16_t* WIN0 = (bf16_t*)(ws + WS_WIN0); bf16_t* WIN1 = (bf16_t*)(ws + WS_WIN1); bf16_t* WOUT0 = (bf16_t*)(ws + WS_WOUT0); bf16_t* WOUT1 = (bf16_t*)(ws + WS_WOUT1);
    bf16_t* WMKV = (bf16_t*)(ws + WS_WMKV); bf16_t* MEMN = (bf16_t*)(ws + WS_MEMN); bf16_t* MKV = (bf16_t*)(ws + WS_MKV);
    float* SSQ0 = (float*)(ws + WS_SSQ0); float* SSQ1 = (float*)(ws + WS_SSQ1); float* SSQ2 = (float*)(ws + WS_SSQ2);
    bf16_t* XB = (bf16_t*)(ws + WS_XB); bf16_t* Z = (bf16_t*)(ws + WS_Z);
    LAS unsigned char* ldsl = (LAS unsigned char*)lds;
    const int lo = args.ph_lo, hi_ph = args.ph_hi;
    volatile LAS unsigned* MISC = (volatile LAS unsigned*)(ldsl + LDS_MISC_OFF);
    if (tid < 32) MISC[tid] = 0u;
    __syncthreads();
    XcdBarrier bar = xcd_barrier_post((unsigned*)(ws + WS_CTL) + CW_BAR, MISC + 8);
#define IN(k) (lo <= (k) && (k) < hi_ph)
#define SEAM(k) do { if (IN(k) && IN((k) + 1)) xcd_barrier(bar); } while (0)
    const int gw = vcu * NWAVES + wave, NGW = G * NWAVES;

    if (IN(0)) {
        LAS float* scr = (LAS float*)(ldsl + wave * 16384);
        constexpr int I_IN0 = (DM / 64) * (IN0 / 32), I_IN1 = (DM / 64) * (IN1 / 32), I_OUT = (MIX / 64) * (DM / 32), I_MKV = (DM / 64) * (DM / 32);
        constexpr int NITEMS = I_IN0 + I_IN1 + 2 * I_OUT + 2 * I_MKV;
        for (int it = gw; it < NITEMS; it += NGW) {
            int r = it;
            if (r < I_IN0) { const int nblk = IN0 / 32, kb = r / nblk, nb = r % nblk; transpose_item(w_in0, IN0, DM, WIN0, 64 * kb, 32 * nb, perm_row0(32 * nb), norm_gain, scr, lane); continue; } r -= I_IN0;
            if (r < I_IN1) { const int nblk = IN1 / 32, kb = r / nblk, nb = r % nblk; transpose_item(w_in1, IN1, DM, WIN1, 64 * kb, 32 * nb, perm_row0(32 * nb), norm_gain + DM, scr, lane); continue; } r -= I_IN1;
            if (r < I_OUT) { const int nblk = DM / 32, kb = r / nblk, nb = r % nblk; transpose_item(w_out0, DM, MIX, WOUT0, 64 * kb, 32 * nb, 32 * nb, nullptr, scr, lane); continue; } r -= I_OUT;
            if (r < I_OUT) { const int nblk = DM / 32, kb = r / nblk, nb = r % nblk; transpose_item(w_out1, DM, MIX, WOUT1, 64 * kb, 32 * nb, 32 * nb, nullptr, scr, lane); continue; } r -= I_OUT;
            { const int l = r / I_MKV; r -= l * I_MKV; const int nblk = DM / 32, kb = r / nblk, nb = r % nblk;
              transpose_item(w_mkv + (size_t)l * DM * DM, DM, DM, WMKV, 64 * kb, 32 * nb, l * DM + 32 * nb, nullptr, scr, lane); }
        }
        for (int m = gw; m < MTOK; m += NGW) {
            const f32x4* xr = (const f32x4*)(x + (size_t)m * DM) + lane; f32x4 v[4]; float s = 0.f;
#pragma unroll
            for (int j = 0; j < 4; ++j) { v[j] = xr[64 * j]; s += (v[j][0] * v[j][0] + v[j][1] * v[j][1]) + (v[j][2] * v[j][2] + v[j][3] * v[j][3]); }
            s = wave_sum(s);
            u32x2* o8 = (u32x2*)(XB + (size_t)m * DM) + lane;
#pragma unroll
            for (int j = 0; j < 4; ++j) { u32x2 w; w.x = pk2(v[j][0], v[j][1]); w.y = pk2(v[j][2], v[j][3]); o8[64 * j] = w; }
            if (lane < 16) SSQ0[(size_t)m * 16 + lane] = lane == 0 ? s : 0.f;
        }
        for (int m = gw; m < NB * MEML; m += NGW) {
            const f32x4* xr = (const f32x4*)(mem + (size_t)m * DM) + lane; const f32x4* gr = (const f32x4*)mem_gain + lane; f32x4 v[4]; float s = 0.f;
#pragma unroll
            for (int j = 0; j < 4; ++j) { v[j] = xr[64 * j]; s += (v[j][0] * v[j][0] + v[j][1] * v[j][1]) + (v[j][2] * v[j][2] + v[j][3] * v[j][3]); }
            s = wave_sum(s); const float rstd = 1.0f / sqrtf(s * (1.0f / DM) + EPSN);
            u32x2* o8 = (u32x2*)(MEMN + (size_t)m * DM) + lane;
#pragma unroll
            for (int j = 0; j < 4; ++j) { const f32x4 g4 = gr[64 * j]; const f32x4 y = v[j] * rstd * g4; u32x2 w; w.x = pk2(y[0], y[1]); w.y = pk2(y[2], y[3]); o8[64 * j] = w; }
        }
        if (bx == 0) {
            for (int i = tid; i < 1024; i += NWAVES * 64) { const int p = i >> 4, k = i & 15;
                const float fr = (float)pow(10000.0, -(double)k / 16.0); const float ang = (float)p * fr;
                tab[TAB_COS + i] = (float)cos((double)ang); tab[TAB_SIN + i] = (float)sin((double)ang); }
            for (int i = tid; i < 8 * 384; i += NWAVES * 64) { const int h = i / 384, e = i % 384; const int rel = e - 191;
                float v = -__builtin_huge_valf();
                if (rel >= -128 && rel <= 128) v = rel_bias[t5_bucket(rel) * 8 + h] * LOG2E;
                tab[TAB_BIASB + i] = v; }
            for (int i = tid; i < 16 * 15 * 32; i += NWAVES * 64) { const int dc = i & 31, hd = i >> 5;
                tab[TAB_RPB + i] = dc < 31 ? rpb_c[hd * 31 + dc] * LOG2E : 0.f; }
        }
    }
    SEAM(0);

#if PROBE_REP & 2
    if (IN(1)) {
        { pg8::Gemm g{XB, WIN0, MTOK, IN0, DM, DM}; pg8::StaticOrder S; S.init(MTOK, IN0, G, bx);
          pg8::EpiIn E{Z, IN0, SSQ0, 0, q_norm, k_norm, tab};
          pg8::gemm_phase<pg8::EpiIn, pg8::StaticOrder, true>(ldsl, g, S, E); }
        { pg8::Gemm g{MEMN, WMKV, NB * MEML, 2 * DM, DM, DM}; pg8::StaticOrder S; S.init(NB * MEML, 2 * DM, G, bx);
          pg8::EpiPlain E{MKV, 2 * DM};
          pg8::gemm_phase<pg8::EpiPlain, pg8::StaticOrder, true>(ldsl, g, S, E); }
    }
#endif
    if (IN(1)) {
        { pg8::Gemm g{XB, WIN0, MTOK, IN0, DM, DM}; pg8::StaticOrder S; S.init(MTOK, IN0, G, bx);
          pg8::EpiIn E{Z, IN0, SSQ0, 0, q_norm, k_norm, tab};
          pg8::gemm_phase<pg8::EpiIn, pg8::StaticOrder, true>(ldsl, g, S, E); }
        { pg8::Gemm g{MEMN, WMKV, NB * MEML, 2 * DM, DM, DM}; pg8::StaticOrder S; S.init(NB * MEML, 2 * DM, G, bx);
          pg8::EpiPlain E{MKV, 2 * DM};
          pg8::gemm_phase<pg8::EpiPlain, pg8::StaticOrder, true>(ldsl, g, S, E); }
    }
    SEAM(1);

    if (IN(2)) {
        LAS float* ltab = (LAS float*)(ldsl + LDS_TAB_OFF);
        for (int i = tid; i < 8 * 384; i += NWAVES * 64) ltab[i] = tab[TAB_BIASB + i];
        __syncthreads();
        const int r32 = lane & 31, hi = lane >> 5;
        { constexpr int NU = NB * 8 * 16; const int per = (NU + G - 1) / G;
          for (int rep_ = 0; rep_ < ((PROBE_REP & 4) ? 2 : 1); ++rep_) { const bool st_ = (rep_ == ((PROBE_REP & 4) ? 1 : 0)) || args.ph_hi > 100;
          for (int uid = vcu * per; uid < NU && uid < (vcu + 1) * per; ++uid) {
              const int qb = uid & 15, h = (uid >> 4) & 7, b = uid >> 7, kvh = h >> 2;
              const size_t rowb = (size_t)b * SEQ;
              const bf16_t* Qw = Z + (rowb + qb * 256 + wave * 32) * IN0 + Z0_QA + h * 64;
              ga::attn_unit<8>(Qw, Z + rowb * IN0 + Z0_KA + kvh * 64, Z + rowb * IN0 + Z0_VA + kvh * 64, Z + (rowb + qb * 256 + wave * 32) * IN0 + Z0_G + h * 64, (char*)lds, st_);
          } } }
        { constexpr int NU = NB * 2 * 64; const int per = (NU + G - 1) / G;
          for (int rep_ = 0; rep_ < ((PROBE_REP & 8) ? 2 : 1); ++rep_) { const bool st_ = (rep_ == ((PROBE_REP & 8) ? 1 : 0)) || args.ph_hi > 100;
          for (int uid = vcu * per; uid < NU && uid < (vcu + 1) * per; ++uid) {
              const int qc = uid & 63, kvh = (uid >> 6) & 1, b = uid >> 7; const int q0 = qc * 64, h = kvh * 4 + (wave >> 1);
              const size_t rowb = (size_t)b * SEQ; const int qpos0 = q0 + 32 * (wave & 1);
              const int t_lo = q0 - 128 < 0 ? 0 : q0 - 128, t_hi = q0 + 192 > SEQ ? SEQ : q0 + 192;
              sa::FWindow f{t_lo, qpos0, sink_b[h] * LOG2E, ltab + h * 384, r32, hi};
              sa::unit<64, sa::FWindow>((char*)lds, Z + (rowb + qpos0) * IN0 + Z0_QB + h * 64, IN0, Z + rowb * IN0 + Z0_KB + kvh * 64, Z + rowb * IN0 + Z0_VB + kvh * 64, IN0, (t_hi - t_lo) / 64, f,
                                        Z + (rowb + qpos0) * IN0 + Z0_G + 512 + h * 64, IN0, st_);
          } } }
        { constexpr int NU = NB * 4 * 16; const int per = (NU + G - 1) / G;
          for (int rep_ = 0; rep_ < ((PROBE_REP & 16) ? 2 : 1); ++rep_) { const bool st_ = (rep_ == ((PROBE_REP & 16) ? 1 : 0)) || args.ph_hi > 100;
          for (int uid = vcu * per; uid < NU && uid < (vcu + 1) * per; ++uid) {
              const int qb = uid & 15, hm = (uid >> 4) & 3, b = uid >> 6; const size_t rowb = (size_t)b * SEQ;
              sa::FDense f;
              sa::unit<128, sa::FDense>((char*)lds, Z + (rowb + qb * 256 + wave * 32) * IN0 + Z0_QM + hm * 128, IN0, MKV + (size_t)b * MEML * 2048 + hm * 128, MKV + (size_t)b * MEML * 2048 + 512 + hm * 128, 2048, MEML / 64, f,
                                        Z + (rowb + qb * 256 + wave * 32) * IN0 + Z0_G + 1024 + hm * 128, IN0, st_);
          } } }
    }
    SEAM(2);

#if PROBE_REP & 32
    if (IN(3)) {
        pg8::Gemm g{Z + Z0_G, WOUT0, MTOK, DM, MIX, IN0}; pg8::StaticOrder S; S.init(MTOK, DM, G, bx);
        pg8::EpiOut E{x, out, XB, SSQ1};
        pg8::gemm_phase<pg8::EpiOut, pg8::StaticOrder, true>(ldsl, g, S, E);
    }
#endif
    if (IN(3)) {
        pg8::Gemm g{Z + Z0_G, WOUT0, MTOK, DM, MIX, IN0}; pg8::StaticOrder S; S.init(MTOK, DM, G, bx);
        pg8::EpiOut E{x, out, XB, SSQ1};
        pg8::gemm_phase<pg8::EpiOut, pg8::StaticOrder, true>(ldsl, g, S, E);
    }
    SEAM(3);

#if PROBE_REP & 64
    if (IN(4)) {
        pg8::Gemm g{XB, WIN1, MTOK, IN1, DM, DM}; pg8::StaticOrder S; S.init(MTOK, IN1, G, bx);
        pg8::EpiIn E{Z, IN1, SSQ1, 1, q_norm, k_norm, tab};
        pg8::gemm_phase<pg8::EpiIn, pg8::StaticOrder, true>(ldsl, g, S, E);
    }
#endif
    if (IN(4)) {
        pg8::Gemm g{XB, WIN1, MTOK, IN1, DM, DM}; pg8::StaticOrder S; S.init(MTOK, IN1, G, bx);
        pg8::EpiIn E{Z, IN1, SSQ1, 1, q_norm, k_norm, tab};
        pg8::gemm_phase<pg8::EpiIn, pg8::StaticOrder, true>(ldsl, g, S, E);
    }
    SEAM(4);

    if (IN(5)) {
        { constexpr int NU = NB * 16 * 32; const int per = (NU + G - 1) / G;
          for (int rep_ = 0; rep_ < ((PROBE_REP & 128) ? 2 : 1); ++rep_) { const bool st_ = (rep_ == ((PROBE_REP & 128) ? 1 : 0)) || args.ph_hi > 100;
          int cur_h = -1;
          for (int it = 0; it < per; ++it) {
              const int uid = (G == 256) ? (((vcu >> 5) * per + it) * 32 + (vcu & 31)) : (vcu * per + it);
              if (uid >= NU) break;
              const int rp = uid & 31, h = (uid >> 5) & 15, b = uid >> 9;
              if (h != cur_h) {
                  LAS float* lt = (LAS float*)(ldsl + na::OFF_TAB);
                  for (int i = tid; i < 15 * 64; i += NWAVES * 64) { const int dr = i >> 6, dc = (i & 63) - 16; lt[i] = (dc >= 0 && dc < 31) ? tab[TAB_RPB + (h * 15 + dr) * 32 + dc] : 0.f; }
                  cur_h = h;
                  asm volatile("s_waitcnt vmcnt(0) lgkmcnt(0)\n\ts_barrier" ::: "memory");
              }
              na::unit((char*)lds, Z + (size_t)b * SEQ * IN1, h, 2 * rp, st_);
          } } }
        { constexpr int NU = NB * 4 * 16; const int per = (NU + G - 1) / G;
          for (int rep_ = 0; rep_ < ((PROBE_REP & 256) ? 2 : 1); ++rep_) { const bool st_ = (rep_ == ((PROBE_REP & 256) ? 1 : 0)) || args.ph_hi > 100;
          for (int uid = vcu * per; uid < NU && uid < (vcu + 1) * per; ++uid) {
              const int qb = uid & 15, hm = (uid >> 4) & 3, b = uid >> 6; const size_t rowb = (size_t)b * SEQ;
              sa::FDense f;
              sa::unit<128, sa::FDense>((char*)lds, Z + (rowb + qb * 256 + wave * 32) * IN1 + Z1_QM + hm * 128, IN1, MKV + (size_t)b * MEML * 2048 + 1024 + hm * 128, MKV + (size_t)b * MEML * 2048 + 1024 + 512 + hm * 128, 2048, MEML / 64, f,
                                        Z + (rowb + qb * 256 + wave * 32) * IN1 + Z1_G + 1024 + hm * 128, IN1, st_);
          } } }
    }
    SEAM(5);

    if (IN(6)) {
        pg8::Gemm g{Z + Z1_G, WOUT1, MTOK, DM, MIX, IN1}; pg8::StaticOrder S; S.init(MTOK, DM, G, bx);
        pg8::EpiOut E{out, out, XB, SSQ2};
        pg8::gemm_phase<pg8::EpiOut, pg8::StaticOrder, true>(ldsl, g, S, E);
    }
    SEAM(6);

    if (IN(7)) {
        for (int m = gw; m < MTOK; m += NGW) {
            f32x4* xr = (f32x4*)(out + (size_t)m * DM) + lane; const f32x4* gr = (const f32x4*)fin_gain + lane;
            float s = lane < 16 ? SSQ2[(size_t)m * 16 + lane] : 0.f; s = wave_sum(s);
            const float rstd = 1.0f / sqrtf(s * (1.0f / DM) + EPSN);
#pragma unroll
            for (int j = 0; j < 4; ++j) { const f32x4 v = xr[64 * j]; xr[64 * j] = v * rstd * gr[64 * j]; }
        }
    }
#undef IN
#undef SEAM
}

#ifndef MK_N_LAUNCHES
#define MK_N_LAUNCHES 1
#endif
extern "C" void kernel_launch(void* const* d_in, const int* in_sizes, int n_in, void* d_out, int out_size, void* d_ws, size_t ws_size, hipStream_t stream) {
    static int grid = 0;
    if (grid == 0) {
        if (n_in != 15 || out_size != MTOK * DM || ws_size < WS_END) { fprintf(stderr, "kernel_launch: unexpected shapes (n_in %d out %d ws %zu)\n", n_in, out_size, ws_size); grid = -1; return; }
        int dev = 0, cus = 0, per_cu = 0;
        hipGetDevice(&dev); hipDeviceGetAttribute(&cus, hipDeviceAttributeMultiprocessorCount, dev);
        hipFuncSetAttribute((const void*)fwd_kernel, hipFuncAttributeMaxDynamicSharedMemorySize, LDS_BYTES);
        hipOccupancyMaxActiveBlocksPerMultiprocessor(&per_cu, (const void*)fwd_kernel, NWAVES * 64, LDS_BYTES);
        (void)hipGetLastError();
        if (per_cu < 1) { fprintf(stderr, "kernel_launch: occupancy query says %d blocks per CU\n", per_cu); per_cu = 1; }
        grid = cus;
    }
    if (grid < 0) return;
    Args a{};
    for (int i = 0; i < 15; ++i) a.in[i] = (const float*)d_in[i];
    a.out = (float*)d_out; a.ws = (unsigned char*)d_ws;
    if (hipMemsetAsync((char*)d_ws + WS_CTL, 0, CTL_ZERO_BYTES, stream) != hipSuccess) { fprintf(stderr, "kernel_launch: memset of the control words failed\n"); return; }
    if (MK_N_LAUNCHES == 1) {
        a.ph_lo = 0; a.ph_hi = 8;
        hipLaunchKernelGGL(fwd_kernel, dim3(grid), dim3(NWAVES * 64), LDS_BYTES, stream, a);
    } else {
        for (int p = 0; p < 8; ++p) { a.ph_lo = p; a.ph_hi = p + 1; hipLaunchKernelGGL(fwd_kernel, dim3(grid), dim3(NWAVES * 64), LDS_BYTES, stream, a); }
    }
}
```

```cpp
#include <hip/hip_runtime.h>
#include <hip/hip_bf16.h>
#include <cstdio>
#include <cstdint>
#include <cmath>

#define LAS __attribute__((address_space(3)))
#define DEV __device__ __forceinline__
typedef unsigned short bf16_t;
typedef short bf16x8 __attribute__((ext_vector_type(8)));
typedef short s16x4 __attribute__((ext_vector_type(4)));
typedef float f32x4 __attribute__((ext_vector_type(4)));
typedef float f32x16 __attribute__((ext_vector_type(16)));
typedef unsigned u32x4 __attribute__((ext_vector_type(4)));
typedef unsigned u32x2 __attribute__((ext_vector_type(2)));

constexpr int NB = 8, SEQ = 4096, DM = 1024, MTOK = NB * SEQ, MEML = 256;
constexpr int IN0 = 3584, IN1 = 5120, MIX = 1536;
constexpr float EPSN = 1e-6f;
constexpr float LOG2E = 1.4426950408889634f;
constexpr float C2_64 = 0.125f * LOG2E;
constexpr float C2_128 = 0.08838834764831845f * LOG2E;
constexpr int Z0_QA = 0, Z0_KA = 512, Z0_VA = 640, Z0_QB = 768, Z0_KB = 1280, Z0_VB = 1408, Z0_QM = 1536, Z0_G = 2048;
constexpr int Z1_QC = 0, Z1_KC = 1024, Z1_VC = 2048, Z1_QM = 3072, Z1_G = 3584;

constexpr size_t MiB = 1u << 20;
constexpr size_t WS_CTL = 0;
constexpr size_t WS_TAB = 1 * MiB;
constexpr int TAB_COS = 0, TAB_SIN = 1024, TAB_BIASB = 2048, TAB_RPB = 2048 + 8 * 384, TAB_END = TAB_RPB + 16 * 15 * 32;
constexpr size_t WS_WIN0 = 2 * MiB, WS_WIN1 = 9 * MiB, WS_WOUT0 = 19 * MiB, WS_WOUT1 = 22 * MiB, WS_WMKV = 25 * MiB, WS_MEMN = 29 * MiB, WS_MKV = 33 * MiB;
constexpr size_t WS_SSQ0 = 41 * MiB, WS_SSQ1 = 43 * MiB, WS_SSQ2 = 45 * MiB;
constexpr size_t WS_XB = 48 * MiB, WS_Z = 112 * MiB, WS_END = 432 * MiB;

constexpr int RING_BYTES = 131072;
constexpr int LDS_TAB_OFF = 98304;
constexpr int LDS_MISC_OFF = 131072 + 320;
constexpr int LDS_BYTES = 147456;
constexpr int CW_BAR = 4096;
constexpr size_t CTL_ZERO_BYTES = 65536;

DEV unsigned f2bf(float f) { unsigned u = __builtin_bit_cast(unsigned, f); return (u + 0x7fffu + ((u >> 16) & 1u)) >> 16; }
typedef float f32x2_t __attribute__((ext_vector_type(2))); typedef __bf16 bf16x2_t __attribute__((ext_vector_type(2)));
DEV unsigned pk2(float lo, float hi) { f32x2_t v = {lo, hi}; bf16x2_t b = __builtin_convertvector(v, bf16x2_t); return __builtin_bit_cast(unsigned, b); }
DEV float bflo(unsigned u) { return __builtin_bit_cast(float, u << 16); }
DEV float bfhi(unsigned u) { return __builtin_bit_cast(float, u & 0xffff0000u); }
DEV float wave_sum(float v) {
#pragma unroll
    for (int o = 1; o < 64; o <<= 1) v += __shfl_xor(v, o);
    return v;
}

namespace pg8 {
constexpr int BM = 256, BK = 64, HALF = 128, HTB = HALF * BK * 2, STAGE_BYTES = 8 * HTB, NXCD = 8, WGM = 8;
__host__ __device__ __forceinline__ int lds_byte(int r, int c) { const int st = (r >> 4) * 2 + (c >> 5), rr = r & 15, cc = c & 31, ob = rr * 64 + cc * 2; return st * 1024 + (ob ^ (((ob >> 9) & 1) << 5)); }
__host__ __device__ __forceinline__ void stage_rc(int b, int& R, int& C) { const int st = b / 1024, sb = b % 1024, swz = sb ^ (((sb >> 9) & 1) << 5); R = (st >> 1) * 16 + swz / 64; C = (st & 1) * 32 + (swz % 64) / 2; }

struct Unit { int pm, pn; };
struct Gemm { const bf16_t* A; const bf16_t* Bt; int M, N, K, lda; };

struct StaticOrder {
    int nM, nN, nwg, G, c;
    __host__ __device__ void init(int M, int N, int G_, int c_) { nM = M / BM; nN = N / BM; nwg = nM * nN; G = G_; c = c_; }
    __host__ __device__ bool next(int i, Unit& u) const {
        const long L = (long)i * G + c; if (L >= nwg) return false;
        int wgid = (int)L; { const int q = nwg / NXCD, r = nwg % NXCD, xcd = wgid % NXCD, off = wgid / NXCD; wgid = (xcd < r ? xcd * (q + 1) : r * (q + 1) + (xcd - r) * q) + off; }
        const int nig = WGM * nN, gid = wgid / nig, fm = gid * WGM, gsz = (nM - fm) < WGM ? (nM - fm) : WGM;
        u.pm = fm + ((wgid % nig) % gsz); u.pn = (wgid % nig) / gsz; return true;
    }
};

template <class Epi, class Sched, bool ALIGN_EPI = false>
__device__ __forceinline__ void gemm_phase(LAS unsigned char* lds, const Gemm g, const Sched& S, const Epi& E) {
    const int tid = threadIdx.x, wid = __builtin_amdgcn_readfirstlane(tid >> 6), lane = tid & 63, wr = wid >> 2, wc = wid & 3, fr = lane & 15, fq = lane >> 4;
    const int K = g.K, nt = K / BK, lda = g.lda;
    unsigned voffA[2], voffB[2];
#pragma unroll
    for (int i = 0; i < 2; ++i) { int R, C; stage_rc(tid * 16 + i * 8192, R, C);
        voffA[i] = (unsigned)(R * lda + C) * 2u; voffB[i] = (unsigned)(R * K + C) * 2u; }
    const size_t kstep = (size_t)(BK * 2);
    const size_t hstepA = (size_t)HALF * lda * 2, hstepB = (size_t)HALF * K * 2;
    const size_t tstepA = 2 * hstepA, tstepB = 2 * hstepB;
    const unsigned ldsw = (unsigned)wid * 1024u;
    const int aoff = lds_byte(wr * 64 + fr, fq * 8), boff = lds_byte(wc * 32 + fr, fq * 8);
#define PG8_SA(b, h) (((b) * 2 + (h)) * HTB)
#define PG8_SB(b, h) ((4 + (b) * 2 + (h)) * HTB)
#define PG8_STAGE(bufoff, gbase, voff) do { _Pragma("unroll") for (int _i = 0; _i < 2; ++_i) \
        __builtin_amdgcn_global_load_lds((const unsigned*)((const char*)(gbase) + (voff)[_i]), (LAS unsigned*)(lds + (bufoff) + ldsw + _i * 8192), 16, 0, 0); } while (0)
#define PG8_LDA(dst, b, h) do { _Pragma("unroll") for (int m = 0; m < 4; ++m) _Pragma("unroll") for (int k = 0; k < 2; ++k) dst[m][k] = *(const LAS bf16x8*)(lds + PG8_SA(b, h) + aoff + m * 2048 + k * 1024); } while (0)
#define PG8_LDB(dst, b, h) do { _Pragma("unroll") for (int n = 0; n < 2; ++n) _Pragma("unroll") for (int k = 0; k < 2; ++k) dst[n][k] = *(const LAS bf16x8*)(lds + PG8_SB(b, h) + boff + n * 2048 + k * 1024); } while (0)
#define PG8_MMA(ai, bj, At, Bt) do { __builtin_amdgcn_s_setprio(1); _Pragma("unroll") for (int m = 0; m < 4; ++m) _Pragma("unroll") for (int n = 0; n < 2; ++n) _Pragma("unroll") for (int k = 0; k < 2; ++k) \
        acc[ai][bj][m][n] = __builtin_amdgcn_mfma_f32_16x16x32_bf16(Bt[n][k], At[m][k], acc[ai][bj][m][n], 0, 0, 0); __builtin_amdgcn_s_setprio(0); } while (0)
#define PG8_WAIT_V(n) asm volatile("s_waitcnt vmcnt(" #n ")" ::: "memory")
#define PG8_WAIT_L(n) asm volatile("s_waitcnt lgkmcnt(" #n ")" ::: "memory")
#define PG8_BAR __builtin_amdgcn_s_barrier()
#define PG8_SCHED __builtin_amdgcn_sched_barrier(0)
    Unit cur, nxt; int ui = 0;
    if (!S.next(0, cur)) return;
    f32x4 acc[2][2][4][2];
#pragma unroll
    for (int a = 0; a < 2; ++a)
#pragma unroll
        for (int b = 0; b < 2; ++b)
#pragma unroll
            for (int m = 0; m < 4; ++m)
#pragma unroll
                for (int n = 0; n < 2; ++n) acc[a][b][m][n] = (f32x4){0.f, 0.f, 0.f, 0.f};
    bf16x8 At[4][2], B0[2][2], B1[2][2];
    const char* cA = (const char*)g.A + (size_t)cur.pm * tstepA; const char* cB = (const char*)g.Bt + (size_t)cur.pn * tstepB;
    PG8_STAGE(PG8_SB(0, 0), cB, voffB); PG8_STAGE(PG8_SB(0, 1), cB + hstepB, voffB); PG8_STAGE(PG8_SA(0, 0), cA, voffA); PG8_STAGE(PG8_SA(0, 1), cA + hstepA, voffA);
    if (wr == 1) PG8_BAR;
    PG8_WAIT_V(2); PG8_BAR;
    PG8_STAGE(PG8_SB(1, 0), cB + kstep, voffB); PG8_STAGE(PG8_SA(1, 0), cA + kstep, voffA); PG8_STAGE(PG8_SB(1, 1), cB + hstepB + kstep, voffB);
    PG8_WAIT_V(6); PG8_BAR;
    for (;;) {
        const bool has_next = S.next(ui + 1, nxt);
        const char* nA = has_next ? (const char*)g.A + (size_t)nxt.pm * tstepA : cA; const char* nB = has_next ? (const char*)g.Bt + (size_t)nxt.pn * tstepB : cB;
        for (int t = 0; t < nt; t += 2) {
            const bool last = (t == nt - 2);
            const char* a1 = cA + (size_t)(t + 1) * kstep;
            const char* a2 = last ? nA : cA + (size_t)(t + 2) * kstep; const char* b2 = last ? nB : cB + (size_t)(t + 2) * kstep;
            const char* a3 = a2 + kstep; const char* b3 = b2 + kstep;
            PG8_LDB(B0, 0, 0); PG8_LDB(B1, 0, 1); PG8_SCHED; PG8_LDA(At, 0, 0); PG8_STAGE(PG8_SA(1, 1), a1 + hstepA, voffA);
            PG8_WAIT_V(8); PG8_WAIT_L(0); PG8_BAR; PG8_MMA(0, 0, At, B0); PG8_MMA(0, 1, At, B1); PG8_BAR; PG8_SCHED;
            PG8_LDA(At, 0, 1); PG8_STAGE(PG8_SB(0, 0), b2, voffB); PG8_STAGE(PG8_SB(0, 1), b2 + hstepB, voffB); PG8_STAGE(PG8_SA(0, 0), a2, voffA);
            PG8_WAIT_V(8); PG8_WAIT_L(0); PG8_BAR; PG8_MMA(1, 0, At, B0); PG8_MMA(1, 1, At, B1); PG8_BAR; PG8_SCHED;
            PG8_LDB(B0, 1, 0); PG8_LDB(B1, 1, 1); PG8_SCHED; PG8_LDA(At, 1, 0); PG8_STAGE(PG8_SA(0, 1), a2 + hstepA, voffA);
            PG8_WAIT_V(8); PG8_WAIT_L(0); PG8_BAR; PG8_MMA(0, 0, At, B0); PG8_MMA(0, 1, At, B1); PG8_BAR; PG8_SCHED;
            PG8_LDA(At, 1, 1); PG8_STAGE(PG8_SB(1, 0), b3, voffB); PG8_STAGE(PG8_SB(1, 1), b3 + hstepB, voffB); PG8_STAGE(PG8_SA(1, 0), a3, voffA);
            PG8_WAIT_V(8); PG8_WAIT_L(0); PG8_BAR; PG8_MMA(1, 0, At, B0); PG8_MMA(1, 1, At, B1); PG8_BAR; PG8_SCHED;
        }
        if constexpr (ALIGN_EPI) { if (wr == 0) PG8_BAR; }
        E(acc, cur, wr, wc, fr, fq);
        if (!has_next) break;
#pragma unroll
        for (int a = 0; a < 2; ++a)
#pragma unroll
            for (int b = 0; b < 2; ++b)
#pragma unroll
                for (int m = 0; m < 4; ++m)
#pragma unroll
                    for (int n = 0; n < 2; ++n) acc[a][b][m][n] = (f32x4){0.f, 0.f, 0.f, 0.f};
        cur = nxt; cA = nA; cB = nB; ++ui;
        if constexpr (ALIGN_EPI) { if (wr == 1) PG8_BAR; }
    }
    PG8_WAIT_V(0);
    if constexpr (!ALIGN_EPI) { if (wr == 0) PG8_BAR; }
    PG8_BAR;
#undef PG8_SA
#undef PG8_SB
#undef PG8_STAGE
#undef PG8_LDA
#undef PG8_LDB
#undef PG8_MMA
#undef PG8_WAIT_V
#undef PG8_WAIT_L
#undef PG8_BAR
#undef PG8_SCHED
}

struct EpiIn {
    bf16_t* Z; int ldz; const float* ssq; int layer; const float* qg; const float* kg; const float* tab;
    __device__ __forceinline__ void operator()(const f32x4 (&acc)[2][2][4][2], const Unit& u, int wr, int wc, int fr, int fq) const {
        const int cb = u.pn * BM + wc * 64;
        int kind = 0; float sc = 1.f; const float* g = qg;
        if (layer == 0) {
            if (cb < Z0_KA) { kind = 1; g = qg; sc = C2_64; }
            else if (cb < Z0_VA) { kind = 1; g = kg; sc = 1.f; }
            else if (cb < Z0_QB) kind = 0;
            else if (cb < Z0_KB) { kind = 2; sc = C2_64; }
            else if (cb < Z0_QM) kind = 0;
            else if (cb < Z0_G) { kind = 2; sc = C2_128; }
            else kind = 3;
        } else {
            if (cb < Z1_KC) { kind = 2; sc = C2_64; }
            else if (cb < Z1_QM) kind = 0;
            else if (cb < Z1_G) { kind = 2; sc = C2_128; }
            else kind = 3;
        }
#pragma unroll
        for (int ai = 0; ai < 2; ++ai)
#pragma unroll
            for (int m = 0; m < 4; ++m) {
                const int row = u.pm * BM + ai * HALF + wr * 64 + m * 16 + fr;
                const f32x4* sp = (const f32x4*)(ssq + (size_t)row * 16);
                const f32x4 s0 = sp[0], s1 = sp[1], s2 = sp[2], s3 = sp[3];
                const float tot = (((s0[0] + s0[1]) + (s0[2] + s0[3])) + ((s1[0] + s1[1]) + (s1[2] + s1[3]))) + (((s2[0] + s2[1]) + (s2[2] + s2[3])) + ((s3[0] + s3[1]) + (s3[2] + s3[3])));
                const float rstd = __builtin_amdgcn_rsqf(tot * (1.0f / DM) + EPSN);
                f32x4 v[2][2];
#pragma unroll
                for (int bj = 0; bj < 2; ++bj)
#pragma unroll
                    for (int n = 0; n < 2; ++n) v[bj][n] = acc[ai][bj][m][n] * rstd;
                if (kind == 1) {
                    float ss = 0.f;
#pragma unroll
                    for (int bj = 0; bj < 2; ++bj)
#pragma unroll
                        for (int n = 0; n < 2; ++n) ss += (v[bj][n][0] * v[bj][n][0] + v[bj][n][1] * v[bj][n][1]) + (v[bj][n][2] * v[bj][n][2] + v[bj][n][3] * v[bj][n][3]);
                    ss += __shfl_xor(ss, 16); ss += __shfl_xor(ss, 32);
                    const float hr = __builtin_amdgcn_rsqf(ss * (1.0f / 64.0f) + EPSN);
#pragma unroll
                    for (int bj = 0; bj < 2; ++bj)
#pragma unroll
                        for (int n = 0; n < 2; ++n) { const f32x4 gv = *(const f32x4*)(g + 32 * bj + 16 * n + 4 * fq); v[bj][n] = v[bj][n] * hr * gv; }
                    const int pos = row & (SEQ - 1);
#pragma unroll
                    for (int bj = 0; bj < 2; ++bj) {
                        const int p = bj == 0 ? (pos >> 6) : (pos & 63);
                        const f32x4 cs = *(const f32x4*)(tab + TAB_COS + p * 16 + 4 * fq), sn = *(const f32x4*)(tab + TAB_SIN + p * 16 + 4 * fq);
                        const f32x4 x1 = v[bj][0], x2 = v[bj][1];
                        v[bj][0] = (x1 * cs - x2 * sn) * sc; v[bj][1] = (x1 * sn + x2 * cs) * sc;
                    }
                } else if (kind == 2) {
#pragma unroll
                    for (int bj = 0; bj < 2; ++bj)
#pragma unroll
                        for (int n = 0; n < 2; ++n) v[bj][n] = v[bj][n] * sc;
                } else if (kind == 3) {
#pragma unroll
                    for (int bj = 0; bj < 2; ++bj)
#pragma unroll
                        for (int n = 0; n < 2; ++n)
#pragma unroll
                            for (int j = 0; j < 4; ++j) { const float x = v[bj][n][j]; v[bj][n][j] = x * __builtin_amdgcn_rcpf(1.0f + __builtin_amdgcn_exp2f(-LOG2E * x)); }
                }
                bf16_t* zp = Z + (size_t)row * ldz + cb + 4 * fq;
#pragma unroll
                for (int bj = 0; bj < 2; ++bj)
#pragma unroll
                    for (int n = 0; n < 2; ++n) { u32x2 w; w.x = pk2(v[bj][n][0], v[bj][n][1]); w.y = pk2(v[bj][n][2], v[bj][n][3]); *(u32x2*)(zp + 32 * bj + 16 * n) = w; }
            }
    }
};
struct EpiPlain {
    bf16_t* O; int ldc;
    __device__ __forceinline__ void operator()(const f32x4 (&acc)[2][2][4][2], const Unit& u, int wr, int wc, int fr, int fq) const {
#pragma unroll
        for (int ai = 0; ai < 2; ++ai)
#pragma unroll
            for (int m = 0; m < 4; ++m) {
                const int row = u.pm * BM + ai * HALF + wr * 64 + m * 16 + fr;
                bf16_t* op = O + (size_t)row * ldc + u.pn * BM + wc * 32 + 4 * fq;
#pragma unroll
                for (int bj = 0; bj < 2; ++bj)
#pragma unroll
                    for (int n = 0; n < 2; ++n) { const f32x4 x = acc[ai][bj][m][n]; u32x2 w; w.x = pk2(x[0], x[1]); w.y = pk2(x[2], x[3]); *(u32x2*)(op + bj * HALF + 16 * n) = w; }
            }
    }
};
struct EpiOut {
    const float* resid; float* xo; bf16_t* xb; float* ssq;
    __device__ __forceinline__ void operator()(const f32x4 (&acc)[2][2][4][2], const Unit& u, int wr, int wc, int fr, int fq) const {
#pragma unroll
        for (int ai = 0; ai < 2; ++ai)
#pragma unroll
            for (int m = 0; m < 4; ++m) {
                const int row = u.pm * BM + ai * HALF + wr * 64 + m * 16 + fr;
                const size_t off = (size_t)row * DM + u.pn * BM + wc * 32 + 4 * fq;
                float ss = 0.f;
#pragma unroll
                for (int bj = 0; bj < 2; ++bj)
#pragma unroll
                    for (int n = 0; n < 2; ++n) {
                        const f32x4 r = *(const f32x4*)(resid + off + bj * HALF + 16 * n);
                        const f32x4 x = acc[ai][bj][m][n] + r;
                        *(f32x4*)(xo + off + bj * HALF + 16 * n) = x;
                        u32x2 w; w.x = pk2(x[0], x[1]); w.y = pk2(x[2], x[3]); *(u32x2*)(xb + off + bj * HALF + 16 * n) = w;
                        ss += (x[0] * x[0] + x[1] * x[1]) + (x[2] * x[2] + x[3] * x[3]);
                    }
                ss += __shfl_xor(ss, 16); ss += __shfl_xor(ss, 32);
                if (fq == 0) ssq[(size_t)row * 16 + u.pn * 4 + wc] = ss;
            }
    }
};
}

namespace sa {
typedef LAS const char* lds_cptr;
#define SBAR() __builtin_amdgcn_sched_barrier(0)
DEV int crow(int r, int hi) { return (r & 3) + 8 * (r >> 2) + 4 * hi; }
DEV void glds16(const void* gsrc, unsigned lds_dst) { unsigned keep;
    asm volatile("s_mov_b32 %0, m0\n\ts_mov_b32 m0, %2\n\ts_nop 0\n\tglobal_load_lds_dwordx4 %1, off\n\ts_mov_b32 m0, %0" : "=&s"(keep) : "v"(gsrc), "s"(lds_dst) : "memory"); }
DEV unsigned cvtpk_s(float lo, float hi) { f32x2_t v = {lo, hi}; bf16x2_t b = __builtin_convertvector(v, bf16x2_t); return __builtin_bit_cast(unsigned, b); }
DEV float rowmax(const f32x16& p0, const f32x16& p1) {
    float a = fmaxf(p0[0], p1[0]);
#pragma unroll
    for (int r = 1; r < 16; ++r) a = fmaxf(a, fmaxf(p0[r], p1[r]));
    auto rr = __builtin_amdgcn_permlane32_swap(__float_as_uint(a), __float_as_uint(a), false, false);
    return fmaxf(__uint_as_float(rr[0]), __uint_as_float(rr[1]));
}
constexpr int OFF_K = 0, OFF_WS = 65536, OFF_OST = 0;
constexpr float NEG_INF = -__builtin_huge_valf();

template <int D, class F>
__device__ __forceinline__ void unit(char* shm, const bf16_t* Qw, int qpitch, const bf16_t* Kt, const bf16_t* Vt, int kvpitch, int nt, const F& f, bf16_t* Ow, int opitch, bool do_store = true) {
    constexpr int SLOT = 64 * D * 2, ND0 = D / 16, NDB = D / 32, NP = D / 64, OFF_V = 2 * SLOT;
    constexpr float THR = 8.0f;
    const int tid = threadIdx.x, lane = tid & 63, r32 = lane & 31, hi = lane >> 5; const int wid = __builtin_amdgcn_readfirstlane(tid >> 6);
    const unsigned lds0 = (unsigned)(uintptr_t)shm;
    const lds_cptr shm3 = (lds_cptr)shm;
    LAS float* wsf = (LAS float*)(shm3 + OFF_WS) + wid * 64;
#define SA_DMA_TILE(j, slotoff) do { const long trow_ = f.tile_row(j); \
    _Pragma("unroll") for (int p_ = 0; p_ < NP; ++p_) { const int c_ = wid + 8 * p_; glds16(Kt + (trow_ + lane) * (long)kvpitch + c_ * 8, (unsigned)__builtin_amdgcn_readfirstlane(lds0 + OFF_K + (slotoff) + c_ * 1024)); } \
    _Pragma("unroll") for (int p_ = 0; p_ < NP; ++p_) { const int bi_ = wid + 8 * p_; glds16(Vt + (trow_ + 16 * (bi_ & 3) + (lane >> 2)) * (long)kvpitch + (bi_ >> 2) * 32 + (lane & 3) * 8, (unsigned)__builtin_amdgcn_readfirstlane(lds0 + OFF_V + (slotoff) + bi_ * 1024)); } } while (0)
    SA_DMA_TILE(0, 0);
    bf16x8 qr[ND0];
#pragma unroll
    for (int d0 = 0; d0 < ND0; ++d0) qr[d0] = *reinterpret_cast<const bf16x8*>(&Qw[(long)r32 * qpitch + d0 * 16 + hi * 8]);
    float mhat = F::has_init ? f.init_m() : 0.f, l_reg = (F::has_init && hi == 0) ? 1.f : 0.f;
    bool started = F::has_init;
    f32x16 o[NDB];
#pragma unroll
    for (int d = 0; d < NDB; ++d) o[d] = f32x16{};
    f32x16 negm;
#pragma unroll
    for (int r = 0; r < 16; ++r) negm[r] = -mhat;
    const int vb0 = (int)(lds0 + OFF_V) + ((lane >> 4) & 1) * 32 + (lane & 3) * 8 + (4 * hi + ((lane & 15) >> 2)) * 64;
    for (int j = 0; j < nt; ++j) {
        const int so = (j & 1) * SLOT;
        if (j + 1 < nt) {
            SA_DMA_TILE(j + 1, ((j + 1) & 1) * SLOT);
            if constexpr (NP == 1) asm volatile("s_waitcnt vmcnt(2) lgkmcnt(0)\n\ts_barrier" ::: "memory");
            else asm volatile("s_waitcnt vmcnt(4) lgkmcnt(0)\n\ts_barrier" ::: "memory");
        } else asm volatile("s_waitcnt vmcnt(0) lgkmcnt(0)\n\ts_barrier" ::: "memory");
        if (f.active(j)) {
            const lds_cptr kp = shm3 + OFF_K + so + hi * 1024 + r32 * 16;
            f32x16 p0, p1;
#pragma unroll
            for (int d0 = 0; d0 < ND0; ++d0) {
                const bf16x8 b0 = *(const LAS bf16x8*)(kp + d0 * 2048), b1 = *(const LAS bf16x8*)(kp + d0 * 2048 + 512);
                if (d0 == 0) { p0 = __builtin_amdgcn_mfma_f32_32x32x16_bf16(b0, qr[0], negm, 0, 0, 0); p1 = __builtin_amdgcn_mfma_f32_32x32x16_bf16(b1, qr[0], negm, 0, 0, 0); }
                else { p0 = __builtin_amdgcn_mfma_f32_32x32x16_bf16(b0, qr[d0], p0, 0, 0, 0); p1 = __builtin_amdgcn_mfma_f32_32x32x16_bf16(b1, qr[d0], p1, 0, 0, 0); }
            }
            f.apply(p0, p1, j);
            const float rm = rowmax(p0, p1);
            if (!started) {
                const float dl = (rm == NEG_INF) ? 0.f : rm;
                mhat = dl;
#pragma unroll
                for (int r = 0; r < 16; ++r) { p0[r] -= dl; p1[r] -= dl; negm[r] = -mhat; }
                started = true;
            } else if (__any(rm > THR)) {
                const float dl = fmaxf(rm, 0.f); mhat += dl;
#pragma unroll
                for (int r = 0; r < 16; ++r) { p0[r] -= dl; p1[r] -= dl; negm[r] = -mhat; }
                const float fs = __builtin_amdgcn_exp2f(-dl); l_reg *= fs;
                if (hi == 0) wsf[r32] = fs;
                asm volatile("s_waitcnt lgkmcnt(0)" ::: "memory");
#pragma unroll
                for (int r = 0; r < 16; ++r) { const float fr_ = wsf[crow(r, hi)];
#pragma unroll
                    for (int d = 0; d < NDB; ++d) o[d][r] *= fr_; }
            }
            float sacc = 0.f;
#pragma unroll
            for (int r = 0; r < 16; ++r) { p0[r] = __builtin_amdgcn_exp2f(p0[r]); p1[r] = __builtin_amdgcn_exp2f(p1[r]); sacc += p0[r] + p1[r]; }
            l_reg += sacc;
            u32x4 pw[4];
#pragma unroll
            for (int q = 0; q < 4; ++q) { pw[0][q] = cvtpk_s(p0[2 * q], p0[2 * q + 1]); pw[1][q] = cvtpk_s(p0[8 + 2 * q], p0[8 + 2 * q + 1]); pw[2][q] = cvtpk_s(p1[2 * q], p1[2 * q + 1]); pw[3][q] = cvtpk_s(p1[8 + 2 * q], p1[8 + 2 * q + 1]); }
            const int vb = vb0 + so;
#pragma unroll
            for (int d0 = 0; d0 < NDB; ++d0) { s16x4 lo[4], hv[4];
#pragma unroll
                for (int ks = 0; ks < 4; ++ks) {
                    asm volatile("ds_read_b64_tr_b16 %0,%1 offset:%c2" : "=&v"(lo[ks]) : "v"(vb), "i"(d0 * 4096 + ks * 1024) : "memory");
                    asm volatile("ds_read_b64_tr_b16 %0,%1 offset:%c2" : "=&v"(hv[ks]) : "v"(vb), "i"(d0 * 4096 + ks * 1024 + 512) : "memory"); }
                asm volatile("s_waitcnt lgkmcnt(0)" ::: "memory"); SBAR();
#pragma unroll
                for (int ks = 0; ks < 4; ++ks) { const bf16x8 vf = (bf16x8){lo[ks][0], lo[ks][1], lo[ks][2], lo[ks][3], hv[ks][0], hv[ks][1], hv[ks][2], hv[ks][3]};
                    o[d0] = __builtin_amdgcn_mfma_f32_32x32x16_bf16(__builtin_bit_cast(bf16x8, pw[ks]), vf, o[d0], 0, 0, 0); }
            }
        }
        asm volatile("s_waitcnt lgkmcnt(0)\n\ts_barrier" ::: "memory");
    }
#undef SA_DMA_TILE
    { auto rr = __builtin_amdgcn_permlane32_swap(__float_as_uint(l_reg), __float_as_uint(l_reg), false, false); l_reg = __uint_as_float(rr[0]) + __uint_as_float(rr[1]); }
    if (hi == 0) wsf[32 + r32] = l_reg;
    asm volatile("s_waitcnt lgkmcnt(0)" ::: "memory");
    LAS bf16_t* stg = (LAS bf16_t*)(shm3 + OFF_OST) + wid * (32 * D);
#pragma unroll
    for (int r = 0; r < 16; ++r) { const int orow = crow(r, hi); const float rli = 1.0f / wsf[32 + orow];
#pragma unroll
        for (int d0 = 0; d0 < NDB; ++d0) stg[orow * D + d0 * 32 + r32] = (bf16_t)f2bf(o[d0][r] * rli); }
    asm volatile("s_waitcnt lgkmcnt(0)" ::: "memory");
    constexpr int CPR = D / 8, NIT = (32 * CPR) / 64;
#pragma unroll
    for (int i = 0; i < NIT; ++i) { const int idx = i * 64 + lane, row = idx / CPR, ch = idx % CPR;
        const u32x4 ov = *(const LAS u32x4*)(stg + row * D + ch * 8);
        bf16_t* gp = Ow + (long)row * opitch + ch * 8;
        const u32x4 gv = *(const u32x4*)gp; u32x4 w;
#pragma unroll
        for (int q = 0; q < 4; ++q) w[q] = pk2(bflo(ov[q]) * bflo(gv[q]), bfhi(ov[q]) * bfhi(gv[q]));
        if (do_store) *(u32x4*)gp = w; }
    asm volatile("s_waitcnt lgkmcnt(0)\n\ts_barrier" ::: "memory");
}
#undef SBAR

struct FDense {
    static constexpr bool has_init = false;
    DEV long tile_row(int j) const { return 64L * j; }
    DEV bool active(int) const { return true; }
    DEV float init_m() const { return 0.f; }
    DEV void apply(f32x16&, f32x16&, int) const {}
};
struct FWindow {
    static constexpr bool has_init = true;
    int t_lo; int qpos0; float sink_l2; LAS const float* tab; int r32, hi;
    DEV long tile_row(int j) const { return t_lo + 64L * j; }
    DEV bool active(int) const { return true; }
    DEV float init_m() const { return sink_l2; }
    DEV void apply(f32x16& p0, f32x16& p1, int j) const {
        LAS const float* tp = tab + (t_lo + 64 * j - qpos0 - r32 + 191 + 4 * hi);
#pragma unroll
        for (int r = 0; r < 16; ++r) { const int o = (r & 3) + 8 * (r >> 2); p0[r] += tp[o]; p1[r] += tp[32 + o]; }
    }
};
struct FNeigh {
    static constexpr bool has_init = false;
    int kr_lo, rq, rs, cq, cs; LAS const float* rpbh; int hi;
    DEV long tile_row(int j) const { return 64L * (kr_lo + j); }
    DEV bool active(int j) const { const int kr = kr_lo + j; return kr >= rs && kr <= rs + 7; }
    DEV float init_m() const { return 0.f; }
    DEV void apply(f32x16& p0, f32x16& p1, int j) const {
        const int dr = kr_lo + j - rq + 7; LAS const float* tp = rpbh + dr * 32;
#pragma unroll
        for (int r = 0; r < 16; ++r) { const int kc = (r & 3) + 8 * (r >> 2) + 4 * hi;
            { const int dc = kc - cq + 15; const bool ok = (unsigned)(kc - cs) < 16u; const float b = tp[dc & 31]; p0[r] = ok ? p0[r] + b : NEG_INF; }
            { const int k2 = kc + 32; const int dc = k2 - cq + 15; const bool ok = (unsigned)(k2 - cs) < 16u; const float b = tp[dc & 31]; p1[r] = ok ? p1[r] + b : NEG_INF; } }
    }
};
}


namespace ga {
using bf16=bf16_t;
constexpr int D=64,DM=IN0;
constexpr int NW=8,QBLK=32,QB=QBLK*NW,KVBLK=64;
__device__ __forceinline__ int crow(int r,int hi){return (r&3)+8*(r>>2)+4*hi;}
#define SBAR() __builtin_amdgcn_sched_barrier(0)
constexpr int NSLOT=3, SLOTB=8192;
constexpr int LDS_K=0, LDS_V=NSLOT*SLOTB, LDS_WS=2*NSLOT*SLOTB, LDS_OST=LDS_WS+NW*64*4, GA_LDS_BYTES=LDS_OST+NW*4096;
constexpr float C2=0.125f*1.4426950408889634f;
__device__ __forceinline__ void glds16(const void*gsrc,unsigned lds_dst){unsigned keep;
  asm volatile("s_mov_b32 %0, m0\n\ts_mov_b32 m0, %2\n\ts_nop 0\n\tglobal_load_lds_dwordx4 %1, off\n\ts_mov_b32 m0, %0":"=&s"(keep):"v"(gsrc),"s"(lds_dst):"memory");}
__device__ __forceinline__ float max3f(float a,float b,float c){float r;asm("v_max3_f32 %0, %1, %2, %3":"=v"(r):"v"(a),"v"(b),"v"(c));return r;}
__device__ __forceinline__ float max2f(float a,float b){float r;asm("v_max_f32_e32 %0, %1, %2":"=v"(r):"v"(a),"v"(b));return r;}
__device__ __forceinline__ float fadd_s(float a,float b){float r;asm("v_add_f32_e32 %0, %1, %2":"=v"(r):"v"(a),"v"(b));return r;}
__device__ __forceinline__ float fsub_s(float a,float b){float r;asm("v_sub_f32_e32 %0, %1, %2":"=v"(r):"v"(a),"v"(b));return r;}
__device__ __forceinline__ unsigned cvtpk_s(float lo,float hi){f32x2_t v={lo,hi};bf16x2_t b=__builtin_convertvector(v,bf16x2_t);return __builtin_bit_cast(unsigned,b);}
#define WAIT_BAR(N) asm volatile("s_waitcnt vmcnt(" #N ") lgkmcnt(0)\n\ts_barrier":::"memory")

__device__ __forceinline__ void qkt(f32x16&p0,f32x16&p1,const char*Kslot,const bf16x8*qr,const f32x16&negm,int r32,int hi){
  const char*kb=Kslot+hi*1024+r32*16;
  #pragma unroll
  for(int d0=0;d0<4;++d0){
    const bf16x8 b0=*reinterpret_cast<const bf16x8*>(kb+d0*2048);
    const bf16x8 b1=*reinterpret_cast<const bf16x8*>(kb+d0*2048+512);
    if(d0==0){p0=__builtin_amdgcn_mfma_f32_32x32x16_bf16(b0,qr[0],negm,0,0,0);p1=__builtin_amdgcn_mfma_f32_32x32x16_bf16(b1,qr[0],negm,0,0,0);}
    else{p0=__builtin_amdgcn_mfma_f32_32x32x16_bf16(b0,qr[d0],p0,0,0,0);p1=__builtin_amdgcn_mfma_f32_32x32x16_bf16(b1,qr[d0],p1,0,0,0);}}
}
typedef __attribute__((address_space(3))) const char* lds_cptr;
typedef short v4i16_t __attribute__((ext_vector_type(4)));
__device__ __forceinline__ void kload8(bf16x8*kf,lds_cptr kp){
  kf[0]=*(const __attribute__((address_space(3))) bf16x8*)(kp);      kf[1]=*(const __attribute__((address_space(3))) bf16x8*)(kp+512);
  kf[2]=*(const __attribute__((address_space(3))) bf16x8*)(kp+2048); kf[3]=*(const __attribute__((address_space(3))) bf16x8*)(kp+2560);
  kf[4]=*(const __attribute__((address_space(3))) bf16x8*)(kp+4096); kf[5]=*(const __attribute__((address_space(3))) bf16x8*)(kp+4608);
  kf[6]=*(const __attribute__((address_space(3))) bf16x8*)(kp+6144); kf[7]=*(const __attribute__((address_space(3))) bf16x8*)(kp+6656);
}
__device__ __forceinline__ void kload2(bf16x8*kf,lds_cptr kp,int j){ kf[2*j]=*(const __attribute__((address_space(3))) bf16x8*)(kp+j*2048); kf[2*j+1]=*(const __attribute__((address_space(3))) bf16x8*)(kp+j*2048+512); }
__device__ __forceinline__ s16x4 vtr(lds_cptr p){ return __builtin_bit_cast(s16x4,__builtin_amdgcn_ds_read_tr16_b64_v4i16((__attribute__((address_space(3))) v4i16_t*)p)); }
__device__ __forceinline__ float rowmax(const f32x16&p0,const f32x16&p1){
  float a=max3f(p0[0],p0[1],p1[0]),b=max3f(p0[2],p0[3],p1[1]);a=max3f(a,p1[2],p1[3]);
  #pragma unroll
  for(int r=4;r<16;r+=4){a=max3f(a,p0[r],p0[r+1]);b=max3f(b,p0[r+2],p0[r+3]);a=max3f(a,p1[r],p1[r+1]);b=max3f(b,p1[r+2],p1[r+3]);}
  const float m=max2f(a,b);
  auto rr=__builtin_amdgcn_permlane32_swap(__float_as_uint(m),__float_as_uint(m),false,false);
  return max2f(__uint_as_float(rr[0]),__uint_as_float(rr[1]));
}
__device__ __forceinline__ void pv(f32x16*o,int vb,bf16x8 pa0,bf16x8 pa1,bf16x8 pa2,bf16x8 pa3){
  #pragma unroll
  for(int d0=0;d0<2;++d0){s16x4 lo[4],hi[4];
    #pragma unroll
    for(int ks=0;ks<4;++ks){
      asm volatile("ds_read_b64_tr_b16 %0,%1 offset:%c2":"=&v"(lo[ks]):"v"(vb),"i"(d0*4096+ks*1024):"memory");
      asm volatile("ds_read_b64_tr_b16 %0,%1 offset:%c2":"=&v"(hi[ks]):"v"(vb),"i"(d0*4096+ks*1024+512):"memory");}
    asm volatile("s_waitcnt lgkmcnt(0)":::"memory");SBAR();
    #define PK(k) (bf16x8){lo[k][0],lo[k][1],lo[k][2],lo[k][3],hi[k][0],hi[k][1],hi[k][2],hi[k][3]}
    o[d0]=__builtin_amdgcn_mfma_f32_32x32x16_bf16(pa0,PK(0),o[d0],0,0,0);
    o[d0]=__builtin_amdgcn_mfma_f32_32x32x16_bf16(pa1,PK(1),o[d0],0,0,0);
    o[d0]=__builtin_amdgcn_mfma_f32_32x32x16_bf16(pa2,PK(2),o[d0],0,0,0);
    o[d0]=__builtin_amdgcn_mfma_f32_32x32x16_bf16(pa3,PK(3),o[d0],0,0,0);
    #undef PK
  }
}

template<int THRL> __device__ __forceinline__ void attn_unit(const bf16*Qw,const bf16*__restrict__ Kh,const bf16*__restrict__ Vh,bf16*Ow,char*shm,bool do_store){
  const int tid=threadIdx.x,lane=tid&63,r32=lane&31,hi=lane>>5; const int wid=__builtin_amdgcn_readfirstlane(tid>>6);
  const unsigned lds0=(unsigned)(uintptr_t)shm;
  LAS float*wsf=(LAS float*)((LAS char*)shm+LDS_WS)+wid*64;
  const bf16*ksrc=Kh+(long)lane*DM+wid*8;
  const bf16*vsrc=Vh+(long)(16*(wid&3)+(lane>>2))*DM+(wid>>2)*32+(lane&3)*8;
  const unsigned kdst=lds0+LDS_K+wid*1024, vdst=lds0+LDS_V+wid*1024;
  #define DMA_K(t,slot) glds16(ksrc+(long)(t)*KVBLK*DM,(unsigned)__builtin_amdgcn_readfirstlane(kdst+(slot)))
  #define DMA_V(t,slot) glds16(vsrc+(long)(t)*KVBLK*DM,(unsigned)__builtin_amdgcn_readfirstlane(vdst+(slot)))
  const int vb0=(int)(lds0+LDS_V)+((lane>>4)&1)*32+(lane&3)*8+(4*hi+((lane&15)>>2))*64;
  const char*Kbase=shm+LDS_K; bf16x8 kf[8];
  const lds_cptr shm3=(lds_cptr)shm; const lds_cptr kp0=shm3+LDS_K+hi*1024+r32*16; const lds_cptr vp0=shm3+LDS_V+((lane>>4)&1)*32+(lane&3)*8+(4*hi+((lane&15)>>2))*64;
  constexpr int NT=SEQ/KVBLK;
  DMA_K(0,0);DMA_V(0,0);DMA_K(1,SLOTB);
  bf16x8 qr[4];
  #pragma unroll
  for(int d0=0;d0<4;++d0)qr[d0]=*reinterpret_cast<const bf16x8*>(&Qw[(long)r32*DM+d0*16+hi*8]);
  float mhat=0.f,l_reg=0.f;f32x16 o[2];o[0]=f32x16{};o[1]=f32x16{};f32x16 negm=f32x16{};asm volatile("":"+v"(negm));
  #define CMASK(P0,P1,t) do{}while(0)
  bool resc=false;
  #define START(P0,P1) do{ const float rm=rowmax(P0,P1); resc=false; \
    { const float dl=rm; mhat=fadd_s(mhat,dl); \
      _Pragma("unroll") for(int r=0;r<16;++r){P0[r]=fsub_s(P0[r],dl);P1[r]=fsub_s(P1[r],dl);} \
      _Pragma("unroll") for(int r=0;r<16;++r)negm[r]=-mhat; asm volatile("":"+v"(negm)); } \
    _Pragma("unroll") for(int r=0;r<16;++r)P0[r]=__builtin_amdgcn_exp2f(P0[r]); }while(0)
  #define RESC() do{ if(resc){ asm volatile("s_waitcnt lgkmcnt(0)":::"memory"); \
      _Pragma("unroll") for(int d_=0;d_<2;++d_) _Pragma("unroll") for(int r=0;r<16;++r)o[d_][r]*=wsf[crow(r,hi)]; } }while(0)
  f32x16 pA0,pA1,pB0,pB1;
  int sl_prev=0,sl_cur=0,sl_next=SLOTB;
  #define ROT() do{sl_prev=sl_cur;sl_cur=sl_next;sl_next=(sl_next==(NSLOT-1)*SLOTB)?0:sl_next+SLOTB;}while(0)
  DMA_K(2,2*SLOTB);
  WAIT_BAR(3);
  qkt(pA0,pA1,Kbase,qr,negm,r32,hi);asm volatile("s_nop 15\n\ts_nop 7":"+v"(pA0),"+v"(pA1));CMASK(pA0,pA1,0);
  START(pA0,pA1);
  _Pragma("unroll") for(int r=0;r<16;++r)pA1[r]=__builtin_amdgcn_exp2f(pA1[r]);
  WAIT_BAR(0);
  DMA_K(3,0);DMA_V(1,SLOTB);
  ROT();
  kload8(kf,kp0+sl_cur);
  WAIT_BAR(2);
  s16x4 vlo[8],vhi[8]; u32x4 pw0,pw1,pw2,pw3;
  #define PKW(P,B) cvtpk_s(P[B],P[B+1])
  #define PAF(k) __builtin_bit_cast(bf16x8,pw##k)
  #define VFR(i) (bf16x8){vlo[i][0],vlo[i][1],vlo[i][2],vlo[i][3],vhi[i][0],vhi[i][1],vhi[i][2],vhi[i][3]}
  #define PIN(x) asm volatile("":"+v"(x))
  #define MX3(a,b,c) __builtin_fmaxf(__builtin_fmaxf((a),(b)),(c))
  #define GAPA(MF,A0,A1,A2,A3,W0,W1,PW) do{ MF; sacc+=A0; sacc+=A1; sacc+=A2; sacc+=A3; PIN(sacc); W0; W1; PIN(PW); SBAR(); }while(0)
  #define EX(v) __builtin_amdgcn_exp2f(v)
  #define GAPB(MF,X,B) do{ MF; X[B]=EX(X[B]); X[B+1]=EX(X[B+1]); X[B+2]=EX(X[B+2]); X[B+3]=EX(X[B+3]); PIN(X); SBAR(); }while(0)
  #define VRD(i) do{ vlo[i]=vtr(vp_+(((i)>>2)*4096+((i)&3)*1024)); vhi[i]=vtr(vp_+(((i)>>2)*4096+((i)&3)*1024+512)); }while(0)
  #define KRD(G,j) do{ if(G){ kload2(kf,kp0+sl_next,j); SBAR(); } }while(0)
  #define STEP(C0,C1,P0,P1,t,GK,GV,GL) do{ SBAR(); \
    const lds_cptr vp_=vp0+sl_prev; \
    VRD(0); SBAR(); float sacc=(P0[0]+P0[1]); \
    GAPA(C0=__builtin_amdgcn_mfma_f32_32x32x16_bf16(kf[0],qr[0],negm,0,0,0), P0[2],P0[3],P0[4],P0[5],     pw0[0]=PKW(P0,0), pw0[1]=PKW(P0,2), pw0); \
    VRD(4); SBAR(); GAPA(C1=__builtin_amdgcn_mfma_f32_32x32x16_bf16(kf[1],qr[0],negm,0,0,0), P0[6],P0[7],P0[8],P0[9],     pw0[2]=PKW(P0,4), pw0[3]=PKW(P0,6), pw0); \
    VRD(1); SBAR(); GAPA(C0=__builtin_amdgcn_mfma_f32_32x32x16_bf16(kf[2],qr[1],C0,0,0,0),   P0[10],P0[11],P0[12],P0[13], pw1[0]=PKW(P0,8), pw1[1]=PKW(P0,10), pw1); \
    VRD(5); SBAR(); GAPA(C1=__builtin_amdgcn_mfma_f32_32x32x16_bf16(kf[3],qr[1],C1,0,0,0),   P0[14],P0[15],P1[0],P1[1],   pw1[2]=PKW(P0,12),pw1[3]=PKW(P0,14), pw1); \
    VRD(2); SBAR(); GAPA(C0=__builtin_amdgcn_mfma_f32_32x32x16_bf16(kf[4],qr[2],C0,0,0,0),   P1[2],P1[3],P1[4],P1[5],     pw2[0]=PKW(P1,0), pw2[1]=PKW(P1,2), pw2); \
    VRD(6); SBAR(); GAPA(C1=__builtin_amdgcn_mfma_f32_32x32x16_bf16(kf[5],qr[2],C1,0,0,0),   P1[6],P1[7],P1[8],P1[9],     pw2[2]=PKW(P1,4), pw2[3]=PKW(P1,6), pw2); \
    VRD(3); SBAR(); GAPA(C0=__builtin_amdgcn_mfma_f32_32x32x16_bf16(kf[6],qr[3],C0,0,0,0),   P1[10],P1[11],P1[12],P1[13], pw3[0]=PKW(P1,8), pw3[1]=PKW(P1,10), pw3); \
    VRD(7); SBAR(); GAPA(C1=__builtin_amdgcn_mfma_f32_32x32x16_bf16(kf[7],qr[3],C1,0,0,0),   P1[14],P1[15],0.f,0.f,       pw3[2]=PKW(P1,12),pw3[3]=PKW(P1,14), pw3); \
    l_reg+=sacc; \
    if(GK){DMA_K((t)+3,sl_cur);} if(GV){DMA_V((t)+1,sl_next);} \
    CMASK(C0,C1,t); \
    { float a=MX3(C0[0],C0[1],C1[0]),b=MX3(C0[2],C0[3],C1[1]); a=MX3(a,C1[2],C1[3]); \
      _Pragma("unroll") for(int r=4;r<16;r+=4){a=MX3(a,C0[r],C0[r+1]);b=MX3(b,C0[r+2],C0[r+3]);a=MX3(a,C1[r],C1[r+1]);b=MX3(b,C1[r+2],C1[r+3]);} \
      float rm=__builtin_fmaxf(a,b); { auto rr=__builtin_amdgcn_permlane32_swap(__float_as_uint(rm),__float_as_uint(rm),false,false); rm=__builtin_fmaxf(__uint_as_float(rr[0]),__uint_as_float(rr[1])); } \
      resc=false; \
      if(__builtin_expect(__any(rm>(float)THRL),0)){ const float dl=__builtin_fmaxf(rm,0.f); mhat+=dl; \
        _Pragma("unroll") for(int r=0;r<16;++r){C0[r]-=dl;C1[r]-=dl;} \
        _Pragma("unroll") for(int r=0;r<16;++r)negm[r]=-mhat; asm volatile("":"+v"(negm)); \
        const float f=__builtin_amdgcn_exp2f(-dl); l_reg*=f; if(hi==0)wsf[r32]=f; resc=true; } } \
    SBAR(); \
    GAPB(o[0]=__builtin_amdgcn_mfma_f32_32x32x16_bf16(PAF(0),VFR(0),o[0],0,0,0), C0,0); \
    GAPB(o[1]=__builtin_amdgcn_mfma_f32_32x32x16_bf16(PAF(0),VFR(4),o[1],0,0,0), C0,4); \
    KRD(GL,0); GAPB(o[0]=__builtin_amdgcn_mfma_f32_32x32x16_bf16(PAF(1),VFR(1),o[0],0,0,0), C0,8); \
    KRD(GL,1); GAPB(o[1]=__builtin_amdgcn_mfma_f32_32x32x16_bf16(PAF(1),VFR(5),o[1],0,0,0), C0,12); \
    KRD(GL,2); GAPB(o[0]=__builtin_amdgcn_mfma_f32_32x32x16_bf16(PAF(2),VFR(2),o[0],0,0,0), C1,0); \
    KRD(GL,3); GAPB(o[1]=__builtin_amdgcn_mfma_f32_32x32x16_bf16(PAF(2),VFR(6),o[1],0,0,0), C1,4); \
    GAPB(o[0]=__builtin_amdgcn_mfma_f32_32x32x16_bf16(PAF(3),VFR(3),o[0],0,0,0), C1,8); \
    GAPB(o[1]=__builtin_amdgcn_mfma_f32_32x32x16_bf16(PAF(3),VFR(7),o[1],0,0,0), C1,12); \
    }while(0)
  int t=1;
  #undef CMASK
  #define CMASK(P0,P1,t) do{}while(0)
  for(;t+5<NT;t+=2){
    STEP(pB0,pB1,pA0,pA1,t,true,true,true);     WAIT_BAR(2); RESC(); ROT();
    STEP(pA0,pA1,pB0,pB1,t+1,true,true,true);   WAIT_BAR(2); RESC(); ROT();
  }
  #undef CMASK
  #define CMASK(P0,P1,t) do{}while(0)
  #define ENDW(tt) do{ if((tt)+3<NT){WAIT_BAR(2);} else if((tt)+2<NT){WAIT_BAR(1);} else {WAIT_BAR(0);} }while(0)
  for(;t+1<NT;t+=2){
    STEP(pB0,pB1,pA0,pA1,t,(t+3<NT),(t+1<NT),(t+1<NT));       ENDW(t);   RESC(); ROT();
    STEP(pA0,pA1,pB0,pB1,t+1,(t+4<NT),(t+2<NT),(t+2<NT));     ENDW(t+1); RESC(); ROT();
  }
  STEP(pB0,pB1,pA0,pA1,NT-1,false,false,false); RESC();
  { float sacc=pB0[0]+pB0[1]; _Pragma("unroll") for(int r=2;r<16;++r)sacc+=pB0[r]; _Pragma("unroll") for(int r=0;r<16;++r)sacc+=pB1[r]; l_reg+=sacc;
    pw0=(u32x4){PKW(pB0,0),PKW(pB0,2),PKW(pB0,4),PKW(pB0,6)};pw1=(u32x4){PKW(pB0,8),PKW(pB0,10),PKW(pB0,12),PKW(pB0,14)};pw2=(u32x4){PKW(pB1,0),PKW(pB1,2),PKW(pB1,4),PKW(pB1,6)};pw3=(u32x4){PKW(pB1,8),PKW(pB1,10),PKW(pB1,12),PKW(pB1,14)};
    SBAR(); pv(o,vb0+sl_cur,PAF(0),PAF(1),PAF(2),PAF(3)); }
  #undef PKW
  #undef PAF
  #undef VFR
  #undef PIN
  #undef MX3
  #undef GAPA
  #undef GAPB
  #undef EX
  #undef VRD
  #undef KRD
  #undef STEP
  #undef ENDW
  {auto rr=__builtin_amdgcn_permlane32_swap(__float_as_uint(l_reg),__float_as_uint(l_reg),false,false);l_reg=__uint_as_float(rr[0])+__uint_as_float(rr[1]);}
  if(hi==0)wsf[32+r32]=l_reg;asm volatile("s_waitcnt lgkmcnt(0)":::"memory");
  float rli[16];
  #pragma unroll
  for(int r=0;r<16;++r)rli[r]=__builtin_amdgcn_rcpf(wsf[32+crow(r,hi)]);
  { LAS bf16*stg=(LAS bf16*)((LAS char*)shm+LDS_OST)+wid*2048;
    #pragma unroll
    for(int r=0;r<16;++r){const int orow=crow(r,hi);
      #pragma unroll
      for(int d0=0;d0<2;++d0)stg[orow*64+d0*32+r32]=(bf16)f2bf(o[d0][r]*rli[r]);}
    asm volatile("s_waitcnt lgkmcnt(0)":::"memory");
    #pragma unroll
    for(int i=0;i<4;++i){const int row=i*8+(lane>>3),ch=lane&7; const u32x4 v=*(const LAS u32x4*)(stg+row*64+ch*8);
      bf16*gp=Ow+(long)row*DM+ch*8; const u32x4 gv=*(const u32x4*)gp; u32x4 w;
      #pragma unroll
      for(int q_=0;q_<4;++q_)w[q_]=pk2(bflo(v[q_])*bflo(gv[q_]),bfhi(v[q_])*bfhi(gv[q_]));
      if(do_store)*(u32x4*)gp=w;} }
  asm volatile("s_waitcnt lgkmcnt(0)\n\ts_barrier":::"memory");
  #undef DMA_K
  #undef DMA_V
  #undef CMASK
  #undef START
  #undef RESC
  #undef ROT
}
constexpr int ATTN_LDS_BYTES=GA_LDS_BYTES;
#undef SBAR
#undef WAIT_BAR
}

namespace na {
typedef LAS const char* lds_cptr;
constexpr int SLOT = 16384, NS = 6, PD = 5, OFF_TAB = NS * SLOT;
constexpr int TAB_FLOATS = 16 + 16 * 15 * 32 + 16;
constexpr float NEG_INF = -__builtin_huge_valf();
DEV int clip(int v, int a, int c) { return v < a ? a : (v > c ? c : v); }
struct CUnit { int b, h, r0, kr_lo, nt; };
DEV CUnit cunit(int it, int vcu, int G, int per) {
    const int uid = (G == 256) ? (((vcu >> 5) * per + it) * 32 + (vcu & 31)) : (vcu * per + it);
    CUnit u; u.r0 = 2 * (uid & 31); u.h = (uid >> 5) & 15; u.b = uid >> 9; u.kr_lo = clip(u.r0 - 4, 0, 56); u.nt = clip(u.r0 - 3, 0, 56) + 7 - u.kr_lo + 1; return u;
}
__device__ __forceinline__ void stream(char* shm, const bf16_t* Z, int vcu, int G, int per, int nun, bool do_store) {
    constexpr float THR = 8.0f;
    const int tid = threadIdx.x, lane = tid & 63, q = lane & 15, g = lane >> 4; const int wid = __builtin_amdgcn_readfirstlane(tid >> 6);
    const unsigned lds0 = (unsigned)(uintptr_t)shm; const lds_cptr shm3 = (lds_cptr)shm;
    LAS const float* ltab = (LAS const float*)(shm3 + OFF_TAB) + 16;
    const int g4 = wid & 3, cq = 16 * g4 + q, rloc = 64 * (wid >> 2) + cq;
    const int kb = g4 == 0 ? 0 : (g4 == 1 ? 8 : (g4 == 2 ? 24 : 32));
    const int cs = clip(cq - 8, 0, 48);
    const int mb = kb + 4 * g - cs;
    const int tbase = kb - cq + 15 + 4 * g;
    const int koff0 = (kb + q) * 128 + ((g ^ (q & 7)) << 4), koff1 = (kb + q) * 128 + (((4 + g) ^ (q & 7)) << 4);
    const int qoff0 = rloc * 128 + ((g ^ (q & 7)) << 4), qoff1 = rloc * 128 + (((4 + g) ^ (q & 7)) << 4);
    const int vrow = kb + 4 * g + (q >> 2), vx = vrow & 7, vp = q & 3;
    unsigned voff[4], goff[4];
#pragma unroll
    for (int db = 0; db < 4; ++db) { voff[db] = (unsigned)(8192 + vrow * 128 + (((2 * db + (vp >> 1)) ^ vx) << 4) + (vp & 1) * 8);
        goff[db] = (unsigned)(rloc * 128 + (((2 * db + (g >> 1)) ^ (q & 7)) << 4) + (g & 1) * 8); }
    const long dsrc = (long)(8 * wid + (lane >> 3)) * IN1 + (((lane & 7) ^ (lane >> 3)) << 3);
    int iu = 0, ik = 0, si = 0, issued = 0; CUnit ip = cunit(0, vcu, G, per);
#define NA_ISSUE() do { if (iu < nun) { \
        const bf16_t* zb_ = Z + (size_t)ip.b * SEQ * IN1 + ip.h * 64; const bf16_t* pa_; const bf16_t* pb_; \
        if (ik == 0) { pa_ = zb_ + (long)(ip.r0 * 64) * IN1 + Z1_QC; pb_ = pa_ + 64L * IN1; } \
        else if (ik == ip.nt + 1) { pa_ = zb_ + (long)(ip.r0 * 64) * IN1 + Z1_G; pb_ = pa_ + 64L * IN1; } \
        else { pa_ = zb_ + (long)((ip.kr_lo + ik - 1) * 64) * IN1 + Z1_KC; pb_ = pa_ + (Z1_VC - Z1_KC); } \
        sa::glds16(pa_ + dsrc, (unsigned)__builtin_amdgcn_readfirstlane(lds0 + si + wid * 1024)); \
        sa::glds16(pb_ + dsrc, (unsigned)__builtin_amdgcn_readfirstlane(lds0 + si + 8192 + wid * 1024)); \
        ++issued; si = si == (NS - 1) * SLOT ? 0 : si + SLOT; \
        if (++ik == ip.nt + 2) { ik = 0; ++iu; if (iu < nun) ip = cunit(iu, vcu, G, per); } } } while (0)
#pragma unroll 1
    for (int k = 0; k < PD; ++k) NA_ISSUE();
    int s = 0, so = 0;
    bf16x8 qf[2]; float mhat = 0.f, l_reg = 0.f; bool started = false;
    f32x4 OT[4]; f32x4 negm = (f32x4){0.f, 0.f, 0.f, 0.f};
#pragma unroll
    for (int d = 0; d < 4; ++d) OT[d] = (f32x4){0.f, 0.f, 0.f, 0.f};
#pragma unroll 1
    for (int it = 0; it < nun; ++it) {
        const CUnit u = cunit(it, vcu, G, per);
        const int rq = u.r0 + (wid >> 2), rs = clip(rq - 4, 0, 56);
        LAS const float* tabh = ltab + u.h * 480 + tbase;
        const int L = u.nt + 2;
#pragma unroll 1
        for (int k = 0; k < L; ++k) {
            const int nafter = issued - 1 - s;
            if (nafter == 4) asm volatile("s_waitcnt vmcnt(8) lgkmcnt(0)\n\ts_barrier" ::: "memory");
            else if (nafter == 3) asm volatile("s_waitcnt vmcnt(6) lgkmcnt(0)\n\ts_barrier" ::: "memory");
            else if (nafter == 2) asm volatile("s_waitcnt vmcnt(4) lgkmcnt(0)\n\ts_barrier" ::: "memory");
            else if (nafter == 1) asm volatile("s_waitcnt vmcnt(2) lgkmcnt(0)\n\ts_barrier" ::: "memory");
            else asm volatile("s_waitcnt vmcnt(0) lgkmcnt(0)\n\ts_barrier" ::: "memory");
            NA_ISSUE();
            const lds_cptr kp = shm3 + so;
            if (k == 0) {
                qf[0] = *(const LAS bf16x8*)(kp + qoff0); qf[1] = *(const LAS bf16x8*)(kp + qoff1);
                mhat = 0.f; l_reg = 0.f; started = false;
#pragma unroll
                for (int d = 0; d < 4; ++d) OT[d] = (f32x4){0.f, 0.f, 0.f, 0.f};
                negm = (f32x4){0.f, 0.f, 0.f, 0.f};
            } else if (k <= u.nt) {
                const int kr = u.kr_lo + k - 1;
                if (kr >= rs && kr <= rs + 7) {
                    const bf16x8 a00 = *(const LAS bf16x8*)(kp + koff0), a01 = *(const LAS bf16x8*)(kp + koff0 + 2048), a10 = *(const LAS bf16x8*)(kp + koff1), a11 = *(const LAS bf16x8*)(kp + koff1 + 2048);
                    f32x4 S0 = __builtin_amdgcn_mfma_f32_16x16x32_bf16(a00, qf[0], negm, 0, 0, 0); S0 = __builtin_amdgcn_mfma_f32_16x16x32_bf16(a10, qf[1], S0, 0, 0, 0);
                    f32x4 S1 = __builtin_amdgcn_mfma_f32_16x16x32_bf16(a01, qf[0], negm, 0, 0, 0); S1 = __builtin_amdgcn_mfma_f32_16x16x32_bf16(a11, qf[1], S1, 0, 0, 0);
                    LAS const float* tp = tabh + (kr - rq + 7) * 32;
                    float bt[8];
#pragma unroll
                    for (int r = 0; r < 4; ++r) { bt[r] = tp[r]; bt[4 + r] = tp[16 + r]; }
                    asm volatile("" : "+v"(bt[0]), "+v"(bt[1]), "+v"(bt[2]), "+v"(bt[3]), "+v"(bt[4]), "+v"(bt[5]), "+v"(bt[6]), "+v"(bt[7]));
#pragma unroll
                    for (int r = 0; r < 4; ++r) {
                        const float x0 = S0[r] + bt[r], x1 = S1[r] + bt[4 + r];
                        S0[r] = ((unsigned)(mb + r) < 16u) ? x0 : NEG_INF;
                        S1[r] = ((unsigned)(mb + 16 + r) < 16u) ? x1 : NEG_INF; }
                    float rm = fmaxf(fmaxf(fmaxf(S0[0], S0[1]), fmaxf(S0[2], S0[3])), fmaxf(fmaxf(S1[0], S1[1]), fmaxf(S1[2], S1[3])));
                    { auto r1 = __builtin_amdgcn_permlane16_swap(__float_as_uint(rm), __float_as_uint(rm), false, false); rm = fmaxf(__uint_as_float(r1[0]), __uint_as_float(r1[1]));
                      auto r2 = __builtin_amdgcn_permlane32_swap(__float_as_uint(rm), __float_as_uint(rm), false, false); rm = fmaxf(__uint_as_float(r2[0]), __uint_as_float(r2[1])); }
                    const bool mv = __any(rm > THR);
                    const float dl = started ? (mv ? fmaxf(rm, 0.f) : 0.f) : ((rm == NEG_INF) ? 0.f : rm);
                    const float fs = started ? __builtin_amdgcn_exp2f(-dl) : 1.0f;
                    mhat += dl; l_reg *= fs; started = true;
#pragma unroll
                    for (int r = 0; r < 4; ++r) { S0[r] -= dl; S1[r] -= dl; negm[r] = -mhat; }
#pragma unroll
                    for (int d = 0; d < 4; ++d) OT[d] = OT[d] * fs;
#pragma unroll
                    for (int r = 0; r < 4; ++r) { S0[r] = __builtin_amdgcn_exp2f(S0[r]); S1[r] = __builtin_amdgcn_exp2f(S1[r]); }
                    l_reg += ((S0[0] + S0[1]) + (S0[2] + S0[3])) + ((S1[0] + S1[1]) + (S1[2] + S1[3]));
                    u32x4 pw; pw[0] = pk2(S0[0], S0[1]); pw[1] = pk2(S0[2], S0[3]); pw[2] = pk2(S1[0], S1[1]); pw[3] = pk2(S1[2], S1[3]);
                    const bf16x8 pf = __builtin_bit_cast(bf16x8, pw);
                    const unsigned vb = lds0 + (unsigned)so;
                    s16x4 lo[4], hv[4];
#pragma unroll
                    for (int db = 0; db < 4; ++db) {
                        asm volatile("ds_read_b64_tr_b16 %0, %1" : "=&v"(lo[db]) : "v"(vb + voff[db]) : "memory");
                        asm volatile("ds_read_b64_tr_b16 %0, %1 offset:2048" : "=&v"(hv[db]) : "v"(vb + voff[db]) : "memory"); }
                    asm volatile("s_waitcnt lgkmcnt(0)" ::: "memory"); __builtin_amdgcn_sched_barrier(0);
#pragma unroll
                    for (int db = 0; db < 4; ++db) {
                        const bf16x8 vf = (bf16x8){lo[db][0], lo[db][1], lo[db][2], lo[db][3], hv[db][0], hv[db][1], hv[db][2], hv[db][3]};
                        OT[db] = __builtin_amdgcn_mfma_f32_16x16x32_bf16(vf, pf, OT[db], 0, 0, 0);
                    }
                }
            } else {
                float lt = l_reg;
                { auto r1 = __builtin_amdgcn_permlane16_swap(__float_as_uint(lt), __float_as_uint(lt), false, false); lt = __uint_as_float(r1[0]) + __uint_as_float(r1[1]);
                  auto r2 = __builtin_amdgcn_permlane32_swap(__float_as_uint(lt), __float_as_uint(lt), false, false); lt = __uint_as_float(r2[0]) + __uint_as_float(r2[1]); }
                const float rl = 1.0f / lt;
                bf16_t* gp = (bf16_t*)Z + ((size_t)u.b * SEQ + u.r0 * 64 + rloc) * IN1 + Z1_G + u.h * 64 + 4 * g;
#pragma unroll
                for (int db = 0; db < 4; ++db) { const u32x2 gv = *(const LAS u32x2*)(kp + goff[db]); const f32x4 o = OT[db] * rl; u32x2 w;
                    w.x = pk2(o[0] * bflo(gv.x), o[1] * bfhi(gv.x)); w.y = pk2(o[2] * bflo(gv.y), o[3] * bfhi(gv.y));
                    if (do_store) *(u32x2*)(gp + 16 * db) = w; }
            }
            ++s; so = so == (NS - 1) * SLOT ? 0 : so + SLOT;
        }
    }
#undef NA_ISSUE
    asm volatile("s_waitcnt vmcnt(0) lgkmcnt(0)\n\ts_barrier" ::: "memory");
}
}


#define GAS __attribute__((address_space(1)))
#define XB_TMO      128
#define XB_XCNT(j)  (256  + 64 * (j))
#define XB_XSUB(j)  (1280 + 64 * (j))
#define XB_XGEN(j)  (2304 + 64 * (j))
#define XB_TOP      3328
#define XB_TOPGEN   3392
#define XCD_BAR_WORDS 3456
#define XB_SPIN_CAP (1u << 18)
__device__ __forceinline__ unsigned xb_ld(unsigned* p)              { return __hip_atomic_load(p, __ATOMIC_RELAXED, __HIP_MEMORY_SCOPE_AGENT); }
__device__ __forceinline__ unsigned xb_add(unsigned* p, unsigned v) { return __hip_atomic_fetch_add(p, v, __ATOMIC_RELAXED, __HIP_MEMORY_SCOPE_AGENT); }
__device__ __forceinline__ unsigned xb_xcc_id() { return (unsigned)__builtin_amdgcn_s_getreg((3 << 11) | 20) & 0xFu; }
#define XB_SPIN(cond, bar) do { unsigned _sp = 0; while (cond) { __builtin_amdgcn_s_sleep(1); \
    if ((++_sp & 255u) == 0u) { if (xb_ld(&(bar)[XB_TMO])) break; if (_sp > XB_SPIN_CAP) { atomicAdd(&(bar)[XB_TMO], 1u); break; } } } } while (0)
struct XcdBarrier { unsigned* bar; unsigned x; volatile LAS unsigned* st; };
__device__ __forceinline__ XcdBarrier xcd_barrier_post(unsigned* bar, volatile LAS unsigned* st) {
    XcdBarrier b; b.bar = bar; b.x = xb_xcc_id(); b.st = st;
    if (threadIdx.x == 0) (void)xb_add(&bar[XB_XCNT(b.x)], 1u);
    return b;
}
__device__ __forceinline__ void xcd_barrier_complete(unsigned* bar, unsigned x, unsigned& nloc, unsigned& nx) {
    const unsigned G = gridDim.x * gridDim.y * gridDim.z;
    unsigned sum, cnt, mine, sp = 0u;
    for (;;) {
        sum = 0u; cnt = 0u; mine = 0u;
#pragma unroll
        for (unsigned j = 0; j < 16; ++j) { const unsigned c = xb_ld(&bar[XB_XCNT(j)]); sum += c; cnt += (c > 0u) ? 1u : 0u; mine = (j == x) ? c : mine; }
        if (sum == G) break;
        __builtin_amdgcn_s_sleep(1);
        if ((++sp & 255u) == 0u) { if (xb_ld(&bar[XB_TMO])) break; if (sp > XB_SPIN_CAP) { atomicAdd(&bar[XB_TMO], 1u); break; } }
    }
    nloc = mine > 0u ? mine : 1u; nx = cnt > 0u ? cnt : 1u;
}
__device__ __forceinline__ void xcd_barrier(const XcdBarrier& b) {
    asm volatile("s_waitcnt vmcnt(0)" ::: "memory");
    __syncthreads();
    if (threadIdx.x == 0) {
        unsigned* bar = b.bar;
        __builtin_amdgcn_s_waitcnt(0);
        unsigned nloc = b.st[0], nx = b.st[1];
        if (nloc == 0u) { xcd_barrier_complete(bar, b.x, nloc, nx); b.st[0] = nloc; b.st[1] = nx; }
        const unsigned old = xb_add(&bar[XB_XSUB(b.x)], 1u);
        const unsigned gen = old / nloc;
        if (old + 1u == (gen + 1u) * nloc) {
            __builtin_amdgcn_fence(__ATOMIC_RELEASE, "agent");
            asm volatile("s_waitcnt vmcnt(0)" ::: "memory");
            const unsigned og = xb_add(&bar[XB_TOP], 1u);
            const unsigned tg = og / nx;
            if (og + 1u == (tg + 1u) * nx) xb_add(&bar[XB_TOPGEN], 1u);
            else XB_SPIN(xb_ld(&bar[XB_TOPGEN]) == tg, bar);
            __builtin_amdgcn_fence(__ATOMIC_ACQUIRE, "agent");
            xb_add(&bar[XB_XGEN(b.x)], 1u);
            asm volatile("s_waitcnt vmcnt(0)" ::: "memory");
        } else {
            XB_SPIN(xb_ld(&bar[XB_XGEN(b.x)]) == gen, bar);
            __builtin_amdgcn_fence(__ATOMIC_ACQUIRE, "agent");
            asm volatile("s_waitcnt vmcnt(0)" ::: "memory");
        }
    }
    __syncthreads();
}
constexpr int NWAVES = 8;
#ifndef PROBE_REP
#define PROBE_REP 0
#endif
struct Args { const float* in[15]; float* out; unsigned char* ws; int ph_lo, ph_hi; };

DEV void transpose_item(const float* W, int N, int K, bf16_t* WT, int k0, int n0, int dst_row0, const float* gain, LAS float* scr, int lane) {
#pragma unroll 8
    for (int i = 0; i < 32; ++i) { const int kk = 2 * i + (lane >> 5); scr[kk * 33 + (lane & 31)] = W[(size_t)(k0 + kk) * N + n0 + (lane & 31)]; }
    asm volatile("s_waitcnt lgkmcnt(0)" ::: "memory");
    const int c = lane & 7;
    float gk[8];
#pragma unroll
    for (int i = 0; i < 8; ++i) gk[i] = gain ? gain[k0 + 8 * c + i] : 1.0f;
#pragma unroll
    for (int j = 0; j < 4; ++j) { const int n = (lane >> 3) + 8 * j; const LAS float* s = scr + (8 * c) * 33 + n;
        u32x4 o; o.x = pk2(s[0 * 33] * gk[0], s[1 * 33] * gk[1]); o.y = pk2(s[2 * 33] * gk[2], s[3 * 33] * gk[3]); o.z = pk2(s[4 * 33] * gk[4], s[5 * 33] * gk[5]); o.w = pk2(s[6 * 33] * gk[6], s[7 * 33] * gk[7]);
        *(u32x4*)(WT + (size_t)(dst_row0 + n) * K + k0 + 8 * c) = o; }
    asm volatile("s_waitcnt lgkmcnt(0)" ::: "memory");
}
DEV int perm_row0(int n0) { const int t = n0 >> 8, gl = (n0 & 255) >> 5, wc = gl >> 1, bj = gl & 1; return (t << 8) + 32 * (4 * bj + wc); }

DEV int t5_bucket(int rel) {
    const int n = rel < 0 ? -rel : rel; int b = rel > 0 ? 16 : 0;
    if (n < 8) return b + n;
    int large = 2 + (31 - __clz(n * n)); if (large > 15) large = 15;
    return b + large;
}

__global__ void __launch_bounds__(NWAVES * 64, 2) fwd_kernel(Args args) {
    extern __shared__ __attribute__((aligned(16))) unsigned char lds[];
    const int tid = threadIdx.x, lane = tid & 63, wave = __builtin_amdgcn_readfirstlane(tid >> 6);
    const int G = gridDim.x; const int bx = blockIdx.x; const int vcu = (G % 8 == 0) ? (bx % 8) * (G / 8) + bx / 8 : bx;
    unsigned char* ws = args.ws;
    const float* x = args.in[0]; const float* mem = args.in[1]; const float* norm_gain = args.in[2]; const float* mem_gain = args.in[3];
    const float* w_in0 = args.in[4]; const float* w_out0 = args.in[5]; const float* q_norm = args.in[6]; const float* k_norm = args.in[7];
    const float* sink_b = args.in[8]; const float* rel_bias = args.in[9]; const float* w_in1 = args.in[10]; const float* w_out1 = args.in[11];
    const float* rpb_c = args.in[12]; const float* w_mkv = args.in[13]; const float* fin_gain = args.in[14];
    float* out = args.out;
    float* tab = (float*)(ws + WS_TAB);
    bf16_t* WIN0 = (bf16_t*)(ws + WS_WIN0); bf16_t* WIN1 = (bf16_t*)(ws + WS_WIN1); bf16_t* WOUT0 = (bf16_t*)(ws + WS_WOUT0); bf16_t* WOUT1 = (bf16_t*)(ws + WS_WOUT1);
    bf16_t* WMKV = (bf16_t*)(ws + WS_WMKV); bf16_t* MEMN = (bf16_t*)(ws + WS_MEMN); bf16_t* MKV = (bf16_t*)(ws + WS_MKV);
    float* SSQ0 = (float*)(ws + WS_SSQ0); float* SSQ1 = (float*)(ws + WS_SSQ1); float* SSQ2 = (float*)(ws + WS_SSQ2);
    bf16_t* XB = (bf16_t*)(ws + WS_XB); bf16_t* Z = (bf16_t*)(ws + WS_Z);
    LAS unsigned char* ldsl = (LAS unsigned char*)lds;
    const int lo = args.ph_lo, hi_ph = args.ph_hi;
    volatile LAS unsigned* MISC = (volatile LAS unsigned*)(ldsl + LDS_MISC_OFF);
    if (tid < 32) MISC[tid] = 0u;
    __syncthreads();
    XcdBarrier bar = xcd_barrier_post((unsigned*)(ws + WS_CTL) + CW_BAR, MISC + 8);
#define IN(k) (lo <= (k) && (k) < hi_ph)
#define SEAM(k) do { if (IN(k) && IN((k) + 1)) xcd_barrier(bar); } while (0)
    const int gw = vcu * NWAVES + wave, NGW = G * NWAVES;

    if (IN(0)) {
        LAS float* scr = (LAS float*)(ldsl + wave * 16384);
        constexpr int I_IN0 = (DM / 64) * (IN0 / 32), I_IN1 = (DM / 64) * (IN1 / 32), I_OUT = (MIX / 64) * (DM / 32), I_MKV = (DM / 64) * (DM / 32);
        constexpr int NITEMS = I_IN0 + I_IN1 + 2 * I_OUT + 2 * I_MKV;
        for (int it = gw; it < NITEMS; it += NGW) {
            int r = it;
            if (r < I_IN0) { const int nblk = IN0 / 32, kb = r / nblk, nb = r % nblk; transpose_item(w_in0, IN0, DM, WIN0, 64 * kb, 32 * nb, perm_row0(32 * nb), norm_gain, scr, lane); continue; } r -= I_IN0;
            if (r < I_IN1) { const int nblk = IN1 / 32, kb = r / nblk, nb = r % nblk; transpose_item(w_in1, IN1, DM, WIN1, 64 * kb, 32 * nb, perm_row0(32 * nb), norm_gain + DM, scr, lane); continue; } r -= I_IN1;
            if (r < I_OUT) { const int nblk = DM / 32, kb = r / nblk, nb = r % nblk; transpose_item(w_out0, DM, MIX, WOUT0, 64 * kb, 32 * nb, 32 * nb, nullptr, scr, lane); continue; } r -= I_OUT;
            if (r < I_OUT) { const int nblk = DM / 32, kb = r / nblk, nb = r % nblk; transpose_item(w_out1, DM, MIX, WOUT1, 64 * kb, 32 * nb, 32 * nb, nullptr, scr, lane); continue; } r -= I_OUT;
            { const int l = r / I_MKV; r -= l * I_MKV; const int nblk = DM / 32, kb = r / nblk, nb = r % nblk;
              transpose_item(w_mkv + (size_t)l * DM * DM, DM, DM, WMKV, 64 * kb, 32 * nb, l * DM + 32 * nb, nullptr, scr, lane); }
        }
        for (int m = gw; m < MTOK; m += NGW) {
            const f32x4* xr = (const f32x4*)(x + (size_t)m * DM) + lane; f32x4 v[4]; float s = 0.f;
#pragma unroll
            for (int j = 0; j < 4; ++j) { v[j] = xr[64 * j]; s += (v[j][0] * v[j][0] + v[j][1] * v[j][1]) + (v[j][2] * v[j][2] + v[j][3] * v[j][3]); }
            s = wave_sum(s);
            u32x2* o8 = (u32x2*)(XB + (size_t)m * DM) + lane;
#pragma unroll
            for (int j = 0; j < 4; ++j) { u32x2 w; w.x = pk2(v[j][0], v[j][1]); w.y = pk2(v[j][2], v[j][3]); o8[64 * j] = w; }
            if (lane < 16) SSQ0[(size_t)m * 16 + lane] = lane == 0 ? s : 0.f;
        }
        for (int m = gw; m < NB * MEML; m += NGW) {
            const f32x4* xr = (const f32x4*)(mem + (size_t)m * DM) + lane; const f32x4* gr = (const f32x4*)mem_gain + lane; f32x4 v[4]; float s = 0.f;
#pragma unroll
            for (int j = 0; j < 4; ++j) { v[j] = xr[64 * j]; s += (v[j][0] * v[j][0] + v[j][1] * v[j][1]) + (v[j][2] * v[j][2] + v[j][3] * v[j][3]); }
            s = wave_sum(s); const float rstd = 1.0f / sqrtf(s * (1.0f / DM) + EPSN);
            u32x2* o8 = (u32x2*)(MEMN + (size_t)m * DM) + lane;
#pragma unroll
            for (int j = 0; j < 4; ++j) { const f32x4 g4 = gr[64 * j]; const f32x4 y = v[j] * rstd * g4; u32x2 w; w.x = pk2(y[0], y[1]); w.y = pk2(y[2], y[3]); o8[64 * j] = w; }
        }
        if (bx == 0) {
            for (int i = tid; i < 1024; i += NWAVES * 64) { const int p = i >> 4, k = i & 15;
                const float fr = (float)pow(10000.0, -(double)k / 16.0); const float ang = (float)p * fr;
                tab[TAB_COS + i] = (float)cos((double)ang); tab[TAB_SIN + i] = (float)sin((double)ang); }
            for (int i = tid; i < 8 * 384; i += NWAVES * 64) { const int h = i / 384, e = i % 384; const int rel = e - 191;
                float v = -__builtin_huge_valf();
                if (rel >= -128 && rel <= 128) v = rel_bias[t5_bucket(rel) * 8 + h] * LOG2E;
                tab[TAB_BIASB + i] = v; }
            for (int i = tid; i < 16 * 15 * 32; i += NWAVES * 64) { const int dc = i & 31, hd = i >> 5;
                tab[TAB_RPB + i] = dc < 31 ? rpb_c[hd * 31 + dc] * LOG2E : 0.f; }
        }
    }
    SEAM(0);

#if PROBE_REP & 2
    if (IN(1)) {
        { pg8::Gemm g{XB, WIN0, MTOK, IN0, DM, DM}; pg8::StaticOrder S; S.init(MTOK, IN0, G, bx);
          pg8::EpiIn E{Z, IN0, SSQ0, 0, q_norm, k_norm, tab};
          pg8::gemm_phase<pg8::EpiIn, pg8::StaticOrder, true>(ldsl, g, S, E); }
        { pg8::Gemm g{MEMN, WMKV, NB * MEML, 2 * DM, DM, DM}; pg8::StaticOrder S; S.init(NB * MEML, 2 * DM, G, bx);
          pg8::EpiPlain E{MKV, 2 * DM};
          pg8::gemm_phase<pg8::EpiPlain, pg8::StaticOrder, true>(ldsl, g, S, E); }
    }
#endif
    if (IN(1)) {
        { pg8::Gemm g{XB, WIN0, MTOK, IN0, DM, DM}; pg8::StaticOrder S; S.init(MTOK, IN0, G, bx);
          pg8::EpiIn E{Z, IN0, SSQ0, 0, q_norm, k_norm, tab};
          pg8::gemm_phase<pg8::EpiIn, pg8::StaticOrder, true>(ldsl, g, S, E); }
        { pg8::Gemm g{MEMN, WMKV, NB * MEML, 2 * DM, DM, DM}; pg8::StaticOrder S; S.init(NB * MEML, 2 * DM, G, bx);
          pg8::EpiPlain E{MKV, 2 * DM};
          pg8::gemm_phase<pg8::EpiPlain, pg8::StaticOrder, true>(ldsl, g, S, E); }
    }
    SEAM(1);

    if (IN(2)) {
        LAS float* ltab = (LAS float*)(ldsl + LDS_TAB_OFF);
        for (int i = tid; i < 8 * 384; i += NWAVES * 64) ltab[i] = tab[TAB_BIASB + i];
        __syncthreads();
        const int r32 = lane & 31, hi = lane >> 5;
        { constexpr int NU = NB * 8 * 16; const int per = (NU + G - 1) / G;
          for (int rep_ = 0; rep_ < ((PROBE_REP & 4) ? 2 : 1); ++rep_) { const bool st_ = (rep_ == ((PROBE_REP & 4) ? 1 : 0)) || args.ph_hi > 100;
          for (int uid = vcu * per; uid < NU && uid < (vcu + 1) * per; ++uid) {
              const int qb = uid & 15, h = (uid >> 4) & 7, b = uid >> 7, kvh = h >> 2;
              const size_t rowb = (size_t)b * SEQ;
              const bf16_t* Qw = Z + (rowb + qb * 256 + wave * 32) * IN0 + Z0_QA + h * 64;
              ga::attn_unit<8>(Qw, Z + rowb * IN0 + Z0_KA + kvh * 64, Z + rowb * IN0 + Z0_VA + kvh * 64, Z + (rowb + qb * 256 + wave * 32) * IN0 + Z0_G + h * 64, (char*)lds, st_);
          } } }
        { constexpr int NU = NB * 2 * 64; const int per = (NU + G - 1) / G;
          for (int rep_ = 0; rep_ < ((PROBE_REP & 8) ? 2 : 1); ++rep_) { const bool st_ = (rep_ == ((PROBE_REP & 8) ? 1 : 0)) || args.ph_hi > 100;
          for (int uid = vcu * per; uid < NU && uid < (vcu + 1) * per; ++uid) {
              const int qc = uid & 63, kvh = (uid >> 6) & 1, b = uid >> 7; const int q0 = qc * 64, h = kvh * 4 + (wave >> 1);
              const size_t rowb = (size_t)b * SEQ; const int qpos0 = q0 + 32 * (wave & 1);
              const int t_lo = q0 - 128 < 0 ? 0 : q0 - 128, t_hi = q0 + 192 > SEQ ? SEQ : q0 + 192;
              sa::FWindow f{t_lo, qpos0, sink_b[h] * LOG2E, ltab + h * 384, r32, hi};
              sa::unit<64, sa::FWindow>((char*)lds, Z + (rowb + qpos0) * IN0 + Z0_QB + h * 64, IN0, Z + rowb * IN0 + Z0_KB + kvh * 64, Z + rowb * IN0 + Z0_VB + kvh * 64, IN0, (t_hi - t_lo) / 64, f,
                                        Z + (rowb + qpos0) * IN0 + Z0_G + 512 + h * 64, IN0, st_);
          } } }
        { constexpr int NU = NB * 4 * 16; const int per = (NU + G - 1) / G;
          for (int rep_ = 0; rep_ < ((PROBE_REP & 16) ? 2 : 1); ++rep_) { const bool st_ = (rep_ == ((PROBE_REP & 16) ? 1 : 0)) || args.ph_hi > 100;
          for (int uid = vcu * per; uid < NU && uid < (vcu + 1) * per; ++uid) {
              const int qb = uid & 15, hm = (uid >> 4) & 3, b = uid >> 6; const size_t rowb = (size_t)b * SEQ;
              sa::FDense f;
              sa::unit<128, sa::FDense>((char*)lds, Z + (rowb + qb * 256 + wave * 32) * IN0 + Z0_QM + hm * 128, IN0, MKV + (size_t)b * MEML * 2048 + hm * 128, MKV + (size_t)b * MEML * 2048 + 512 + hm * 128, 2048, MEML / 64, f,
                                        Z + (rowb + qb * 256 + wave * 32) * IN0 + Z0_G + 1024 + hm * 128, IN0, st_);
          } } }
    }
    SEAM(2);

#if PROBE_REP & 32
    if (IN(3)) {
        pg8::Gemm g{Z + Z0_G, WOUT0, MTOK, DM, MIX, IN0}; pg8::StaticOrder S; S.init(MTOK, DM, G, bx);
        pg8::EpiOut E{x, out, XB, SSQ1};
        pg8::gemm_phase<pg8::EpiOut, pg8::StaticOrder, true>(ldsl, g, S, E);
    }
#endif
    if (IN(3)) {
        pg8::Gemm g{Z + Z0_G, WOUT0, MTOK, DM, MIX, IN0}; pg8::StaticOrder S; S.init(MTOK, DM, G, bx);
        pg8::EpiOut E{x, out, XB, SSQ1};
        pg8::gemm_phase<pg8::EpiOut, pg8::StaticOrder, true>(ldsl, g, S, E);
    }
    SEAM(3);

#if PROBE_REP & 64
    if (IN(4)) {
        pg8::Gemm g{XB, WIN1, MTOK, IN1, DM, DM}; pg8::StaticOrder S; S.init(MTOK, IN1, G, bx);
        pg8::EpiIn E{Z, IN1, SSQ1, 1, q_norm, k_norm, tab};
        pg8::gemm_phase<pg8::EpiIn, pg8::StaticOrder, true>(ldsl, g, S, E);
    }
#endif
    if (IN(4)) {
        pg8::Gemm g{XB, WIN1, MTOK, IN1, DM, DM}; pg8::StaticOrder S; S.init(MTOK, IN1, G, bx);
        pg8::EpiIn E{Z, IN1, SSQ1, 1, q_norm, k_norm, tab};
        pg8::gemm_phase<pg8::EpiIn, pg8::StaticOrder, true>(ldsl, g, S, E);
    }
    SEAM(4);

    if (IN(5)) {
        { constexpr int NU = NB * 16 * 32; const int per = (NU + G - 1) / G; int nun = NU - vcu * per; nun = nun < 0 ? 0 : (nun > per ? per : nun);
          LAS float* lt = (LAS float*)(ldsl + na::OFF_TAB);
          for (int i = tid; i < na::TAB_FLOATS; i += NWAVES * 64) { const int e = i - 16; lt[i] = (e >= 0 && e < 16 * 15 * 32) ? tab[TAB_RPB + e] : 0.f; }
          asm volatile("s_waitcnt vmcnt(0) lgkmcnt(0)\n\ts_barrier" ::: "memory");
          for (int rep_ = 0; rep_ < ((PROBE_REP & 128) ? 2 : 1); ++rep_) { const bool st_ = (rep_ == ((PROBE_REP & 128) ? 1 : 0)) || args.ph_hi > 100;
              na::stream((char*)lds, Z, vcu, G, per, nun, st_); } }
        { constexpr int NU = NB * 4 * 16; const int per = (NU + G - 1) / G;
          for (int rep_ = 0; rep_ < ((PROBE_REP & 256) ? 2 : 1); ++rep_) { const bool st_ = (rep_ == ((PROBE_REP & 256) ? 1 : 0)) || args.ph_hi > 100;
          for (int uid = vcu * per; uid < NU && uid < (vcu + 1) * per; ++uid) {
              const int qb = uid & 15, hm = (uid >> 4) & 3, b = uid >> 6; const size_t rowb = (size_t)b * SEQ;
              sa::FDense f;
              sa::unit<128, sa::FDense>((char*)lds, Z + (rowb + qb * 256 + wave * 32) * IN1 + Z1_QM + hm * 128, IN1, MKV + (size_t)b * MEML * 2048 + 1024 + hm * 128, MKV + (size_t)b * MEML * 2048 + 1024 + 512 + hm * 128, 2048, MEML / 64, f,
                                        Z + (rowb + qb * 256 + wave * 32) * IN1 + Z1_G + 1024 + hm * 128, IN1, st_);
          } } }
    }
    SEAM(5);

    if (IN(6)) {
        pg8::Gemm g{Z + Z1_G, WOUT1, MTOK, DM, MIX, IN1}; pg8::StaticOrder S; S.init(MTOK, DM, G, bx);
        pg8::EpiOut E{out, out, XB, SSQ2};
        pg8::gemm_phase<pg8::EpiOut, pg8::StaticOrder, true>(ldsl, g, S, E);
    }
    SEAM(6);

    if (IN(7)) {
        for (int m = gw; m < MTOK; m += NGW) {
            f32x4* xr = (f32x4*)(out + (size_t)m * DM) + lane; const f32x4* gr = (const f32x4*)fin_gain + lane;
            float s = lane < 16 ? SSQ2[(size_t)m * 16 + lane] : 0.f; s = wave_sum(s);
            const float rstd = 1.0f / sqrtf(s * (1.0f / DM) + EPSN);
#pragma unroll
            for (int j = 0; j < 4; ++j) { const f32x4 v = xr[64 * j]; xr[64 * j] = v * rstd * gr[64 * j]; }
        }
    }
#undef IN
#undef SEAM
}

#ifndef MK_N_LAUNCHES
#define MK_N_LAUNCHES 1
#endif
extern "C" void kernel_launch(void* const* d_in, const int* in_sizes, int n_in, void* d_out, int out_size, void* d_ws, size_t ws_size, hipStream_t stream) {
    static int grid = 0;
    if (grid == 0) {
        if (n_in != 15 || out_size != MTOK * DM || ws_size < WS_END) { fprintf(stderr, "kernel_launch: unexpected shapes (n_in %d out %d ws %zu)\n", n_in, out_size, ws_size); grid = -1; return; }
        int dev = 0, cus = 0, per_cu = 0;
        hipGetDevice(&dev); hipDeviceGetAttribute(&cus, hipDeviceAttributeMultiprocessorCount, dev);
        hipFuncSetAttribute((const void*)fwd_kernel, hipFuncAttributeMaxDynamicSharedMemorySize, LDS_BYTES);
        hipOccupancyMaxActiveBlocksPerMultiprocessor(&per_cu, (const void*)fwd_kernel, NWAVES * 64, LDS_BYTES);
        (void)hipGetLastError();
        if (per_cu < 1) { fprintf(stderr, "kernel_launch: occupancy query says %d blocks per CU\n", per_cu); per_cu = 1; }
        grid = cus;
    }
    if (grid < 0) return;
    Args a{};
    for (int i = 0; i < 15; ++i) a.in[i] = (const float*)d_in[i];
    a.out = (float*)d_out; a.ws = (unsigned char*)d_ws;
    if (hipMemsetAsync((char*)d_ws + WS_CTL, 0, CTL_ZERO_BYTES, stream) != hipSuccess) { fprintf(stderr, "kernel_launch: memset of the control words failed\n"); return; }
    if (MK_N_LAUNCHES == 1) {
        a.ph_lo = 0; a.ph_hi = 8;
        hipLaunchKernelGGL(fwd_kernel, dim3(grid), dim3(NWAVES * 64), LDS_BYTES, stream, a);
    } else {
        for (int p = 0; p < 8; ++p) { a.ph_lo = p; a.ph_hi = p + 1; hipLaunchKernelGGL(fwd_kernel, dim3(grid), dim3(NWAVES * 64), LDS_BYTES, stream, a); }
    }
}
```
